# Optimizing an MI355X kernel written in HIP

```python
import jax, jax.numpy as jnp
from jax import lax
import numpy as np

D_MODEL = 2048
BATCH = 2
SEQ = 16384
DEPTH = 2

GRID_W = 64
HEAD_DIM = 128
NA_HEADS = D_MODEL // HEAD_DIM
NA_WIN_ROWS = 8
NA_WIN_COLS = 16
DIL_GROUPS = ((128, 1), (512, 4), (2048, 16))
DIL_HEADS = 8
ROPE_THETA = 500000.0
ROPE_DIM = HEAD_DIM // 4
D_FF = 4 * D_MODEL
N_MIXERS = 2
BLOCK_Q = 128
EPS = 1e-6
NEG = -1e30

kernel_name = "hybrid_natten_dilated_encoder"


def rms_norm(x, g):
    xf = x.astype(jnp.float32)
    y = xf * lax.rsqrt(jnp.mean(xf * xf, axis=-1, keepdims=True) + EPS)
    return (y * g.astype(jnp.float32)).astype(x.dtype)


def sq_relu_mlp(h, w1, w2):
    return jnp.square(jax.nn.relu(h @ w1)) @ w2


def neighbourhood_attention(h, w_qkv, rpb, w_o):
    B, T, _ = h.shape
    rows = T // GRID_W
    kh = min(NA_WIN_ROWS, rows)
    kw = NA_WIN_COLS
    qkv = (h @ w_qkv).reshape(B, rows, GRID_W, 3, NA_HEADS, HEAD_DIM)
    q = qkv[:, :, :, 0] * (HEAD_DIM ** -0.5)
    k = qkv[:, :, :, 1]
    v = qkv[:, :, :, 2]
    cols = np.arange(GRID_W)
    col_start = np.clip(cols - kw // 2, 0, GRID_W - kw)
    col_mask = (cols[None, :] >= col_start[:, None]) & (cols[None, :] < col_start[:, None] + kw)
    col_idx = np.clip(cols[None, :] - cols[:, None] + NA_WIN_COLS - 1, 0, 2 * NA_WIN_COLS - 2)
    rpb_cols = rpb[:, :, col_idx].transpose(0, 2, 1, 3)
    mask = jnp.asarray(col_mask)[:, None, :]

    def one_row(r):
        rs = jnp.clip(r - kh // 2, 0, rows - kh)
        q_r = lax.dynamic_index_in_dim(q, r, axis=1, keepdims=False)
        k_r = lax.dynamic_slice_in_dim(k, rs, kh, axis=1)
        v_r = lax.dynamic_slice_in_dim(v, rs, kh, axis=1)
        row_off = rs + jnp.arange(kh) - r
        bias = jnp.take(rpb_cols, row_off + NA_WIN_ROWS - 1, axis=2)
        s = jnp.einsum('bqhd,brwhd->bhqrw', q_r, k_r).astype(jnp.float32)
        s = s + bias.astype(jnp.float32)[None]
        s = jnp.where(mask, s, NEG)
        p = jax.nn.softmax(s, axis=(-2, -1))
        return jnp.einsum('bhqrw,brwhd->bqhd', p.astype(v.dtype), v_r)

    out = lax.map(one_row, jnp.arange(rows))
    out = out.transpose(1, 0, 2, 3, 4).reshape(B, T, NA_HEADS * HEAD_DIM)
    return out @ w_o


def apply_partial_rotary(x, cos, sin):
    half = ROPE_DIM // 2
    x1 = x[..., :half]
    x2 = x[..., half:ROPE_DIM]
    return jnp.concatenate([x1 * cos - x2 * sin, x2 * cos + x1 * sin, x[..., ROPE_DIM:]], axis=-1)


def banded_attention(q, k, v, half):
    L, hd = q.shape[-2], q.shape[-1]
    lead = q.shape[:-2]
    nl = len(lead)
    qb = min(BLOCK_Q, L)
    nb = -(-L // qb)
    pad = nb * qb - L
    qp = jnp.pad(q, [(0, 0)] * nl + [(0, pad), (0, 0)]).reshape(*lead, nb, qb, hd)
    kp = jnp.pad(k, [(0, 0)] * nl + [(half, half + pad), (0, 0)])
    vp = jnp.pad(v, [(0, 0)] * nl + [(half, half + pad), (0, 0)])
    idx = np.arange(nb)[:, None] * qb + np.arange(qb + 2 * half)[None, :]
    kb = jnp.take(kp, idx, axis=-2)
    vb = jnp.take(vp, idx, axis=-2)
    qpos = np.arange(nb)[:, None] * qb + np.arange(qb)[None, :]
    kpos = idx - half
    valid = ((np.abs(kpos[:, None, :] - qpos[:, :, None]) <= half)
             & (kpos[:, None, :] >= 0) & (kpos[:, None, :] < L))
    s = jnp.einsum('...nqd,...nkd->...nqk', qp, kb).astype(jnp.float32)
    s = jnp.where(jnp.asarray(valid), s, NEG)
    lse = jax.nn.logsumexp(s, axis=-1)
    p = jnp.exp(s - lse[..., None])
    o = jnp.einsum('...nqk,...nkd->...nqd', p.astype(v.dtype), vb)
    o = o.reshape(*lead, nb * qb, hd)[..., :L, :]
    lse = lse.reshape(*lead, nb * qb)[..., :L]
    return o, lse


def dilated_attention(h, w_qkv, w_o):
    B, T, _ = h.shape
    G = len(DIL_GROUPS)
    qkv = (h @ w_qkv).reshape(B, T, G, 3, DIL_HEADS, HEAD_DIM)
    pos = jnp.arange(T, dtype=jnp.float32)
    inv_freq = ROPE_THETA ** (-jnp.arange(0, ROPE_DIM, 2, dtype=jnp.float32) / ROPE_DIM)
    ang = pos[:, None] * inv_freq[None, :]
    cos = jnp.cos(ang)[:, None, :].astype(h.dtype)
    sin = jnp.sin(ang)[:, None, :].astype(h.dtype)
    outs, lses = [], []
    for g, (window, dil) in enumerate(DIL_GROUPS):
        L = T // dil
        n_side = (window // 2) // dil

        def split(t):
            return t.reshape(B, L, dil, DIL_HEADS, HEAD_DIM).transpose(0, 3, 2, 1, 4)

        q = apply_partial_rotary(qkv[:, :, g, 0], cos, sin) * (HEAD_DIM ** -0.5)
        k = apply_partial_rotary(qkv[:, :, g, 1], cos, sin)
        v = qkv[:, :, g, 2]
        o, lse = banded_attention(split(q), split(k), split(v), n_side)
        outs.append(o.transpose(0, 3, 2, 1, 4).reshape(B, T, DIL_HEADS, HEAD_DIM))
        lses.append(lse.transpose(0, 3, 2, 1).reshape(B, T, DIL_HEADS))
    wts = jax.nn.softmax(jnp.stack(lses, axis=0), axis=0)
    o = jnp.einsum('gbth,gbthd->bthd', wts.astype(h.dtype), jnp.stack(outs, axis=0))
    return o.reshape(B, T, DIL_HEADS * HEAD_DIM) @ w_o


def setup_inputs(seed: int = 0) -> dict:
    key = jax.random.key(seed)
    ks = jax.random.split(key, 16)
    f32 = jnp.float32
    G = len(DIL_GROUPS)

    def w(k, shape, fan_in):
        return jax.random.normal(k, shape, f32) * (fan_in ** -0.5)

    def gain(k):
        return 1.0 + 0.02 * jax.random.normal(k, (D_MODEL,), f32)

    return {
        "x": jax.random.normal(ks[0], (BATCH, SEQ, D_MODEL), f32),
        "na_norm": gain(ks[1]),
        "na_wqkv": w(ks[2], (D_MODEL, 3 * NA_HEADS * HEAD_DIM), D_MODEL),
        "na_rpb": 0.1 * jax.random.normal(ks[3], (NA_HEADS, 2 * NA_WIN_ROWS - 1, 2 * NA_WIN_COLS - 1), f32),
        "na_wo": w(ks[4], (NA_HEADS * HEAD_DIM, D_MODEL), NA_HEADS * HEAD_DIM),
        "ffn0_norm": gain(ks[5]),
        "ffn0_w1": w(ks[6], (D_MODEL, D_FF), D_MODEL),
        "ffn0_w2": w(ks[7], (D_FF, D_MODEL), D_FF),
        "dil_norm": gain(ks[8]),
        "dil_wqkv": w(ks[9], (D_MODEL, G * 3 * DIL_HEADS * HEAD_DIM), D_MODEL),
        "dil_wo": w(ks[10], (DIL_HEADS * HEAD_DIM, D_MODEL), DIL_HEADS * HEAD_DIM),
        "ffn1_norm": gain(ks[11]),
        "ffn1_w1": w(ks[12], (D_MODEL, D_FF), D_MODEL),
        "ffn1_w2": w(ks[13], (D_FF, D_MODEL), D_FF),
        "final_norm": gain(ks[14]),
    }


def reference(x, na_norm, na_wqkv, na_rpb, na_wo, ffn0_norm, ffn0_w1, ffn0_w2,
              dil_norm, dil_wqkv, dil_wo, ffn1_norm, ffn1_w1, ffn1_w2, final_norm):
    mixer_norms = (na_norm, dil_norm)
    ffns = ((ffn0_norm, ffn0_w1, ffn0_w2), (ffn1_norm, ffn1_w1, ffn1_w2))
    for i in range(DEPTH):
        m = i % N_MIXERS
        hn = rms_norm(x, mixer_norms[m])
        if m == 0:
            x = x + neighbourhood_attention(hn, na_wqkv, na_rpb, na_wo)
        else:
            x = x + dilated_attention(hn, dil_wqkv, dil_wo)
        g, w1, w2 = ffns[i]
        x = x + sq_relu_mlp(rms_norm(x, g), w1, w2)
    return rms_norm(x, final_norm)
```

```cpp
#include <hip/hip_runtime.h>
#include <hip/hip_cooperative_groups.h>
#include <cstdio>
#include <cstdint>
#include <cmath>
namespace cg = cooperative_groups;
namespace pg8 {
#define PG8_LAS __attribute__((address_space(3)))
typedef unsigned short bf16_t;
typedef short bf16x8 __attribute__((ext_vector_type(8)));
typedef float f32x4 __attribute__((ext_vector_type(4)));
typedef unsigned u32x4 __attribute__((ext_vector_type(4)));
constexpr int BM = 256, BK = 64, HALF = 128, HTB = HALF * BK * 2  , STAGE_BYTES = 8 * HTB, NXCD = 8, WGM = 8;

__host__ __device__ __forceinline__ int lds_byte(int r, int c) { const int st = (r >> 4) * 2 + (c >> 5), rr = r & 15, cc = c & 31, ob = rr * 64 + cc * 2; return st * 1024 + (ob ^ (((ob >> 9) & 1) << 5)); }
__host__ __device__ __forceinline__ void stage_rc(int b, int& R, int& C) { const int st = b / 1024, sb = b % 1024, swz = sb ^ (((sb >> 9) & 1) << 5); R = (st >> 1) * 16 + swz / 64; C = (st & 1) * 32 + (swz % 64) / 2; }
__host__ __device__ __forceinline__ int perm32(int rho) { const int n = rho >> 4, i = rho & 15; return 8 * (i >> 2) + 4 * n + (i & 3); }

struct Unit { int pm, pn; };
struct Gemm { const bf16_t* A; const bf16_t* Bt; int M, N, K, lda; };

struct StaticOrder {
    int nM, nN, nwg, G, c, wgm;
    __host__ __device__ void init(int M, int N, int G_, int c_) { nM = M / BM; nN = N / BM; nwg = nM * nN; G = G_; c = c_; wgm = WGM; }
    __host__ __device__ bool next(int i, Unit& u) const {
        const long L = (long)i * G + c; if (L >= nwg) return false;
        int wgid = (int)L; { const int q = nwg / NXCD, r = nwg % NXCD, xcd = wgid % NXCD, off = wgid / NXCD; wgid = (xcd < r ? xcd * (q + 1) : r * (q + 1) + (xcd - r) * q) + off; }
        const int nig = wgm * nN, gid = wgid / nig, fm = gid * wgm, gsz = (nM - fm) < wgm ? (nM - fm) : wgm;
        u.pm = fm + ((wgid % nig) % gsz); u.pn = (wgid % nig) / gsz; return true;
    }
    __device__ __forceinline__ void a_ready(const Unit&) const {}
    __device__ __forceinline__ void done(const Unit&) const {}
};

__device__ __forceinline__ unsigned cvt_pk_bf16(float lo, float hi) { unsigned r; asm volatile("v_cvt_pk_bf16_f32 %0, %1, %2" : "=v"(r) : "v"(lo), "v"(hi)); return r; }
typedef float f32x2 __attribute__((ext_vector_type(2)));
template <class Epi, class Sched, bool ALIGN_EPI = false, bool SP2 = false>
__device__ __forceinline__ void gemm_phase(PG8_LAS unsigned char* lds, const Gemm g, const Sched& S, const Epi& E, int tid_in) {
    int tid_ = tid_in; asm volatile("" : "+v"(tid_)); const int tid = tid_, wid = __builtin_amdgcn_readfirstlane(tid >> 6), lane = tid & 63, wr = wid >> 2, wc = wid & 3, fr = lane & 15, fq = lane >> 4;
    const int K = g.K, nt = K / BK;
    unsigned voffA[2], voffB[2];
#pragma unroll
    for (int i = 0; i < 2; ++i) { int R, C; stage_rc(tid * 16 + i * 8192, R, C); const int Rb = 2 * (R & ~31) + (Epi::PERM ? perm32(R & 31) : (R & 31));
        voffA[i] = (unsigned)(R * g.lda + C) * 2u; voffB[i] = (unsigned)(Rb * K + C) * 2u; }
    const size_t kstep = (size_t)(BK * 2);
    const size_t hstep = (size_t)HALF * g.lda * 2;
    const size_t hstepB = (size_t)32 * K * 2;
    const size_t tstep = 2 * hstep, tstepB = (size_t)BM * K * 2;
    const unsigned ldsw = (unsigned)wid * 1024u;
    const int aoff = lds_byte(wr * 64 + fr, fq * 8), boff = lds_byte(wc * 32 + fr, fq * 8);
#define PG8_SA(b, h) (((b) * 2 + (h)) * HTB)
#define PG8_SB(b, h) ((4 + (b) * 2 + (h)) * HTB)
#define PG8_STAGE(bufoff, gbase, voff) do { _Pragma("unroll") for (int _i = 0; _i < 2; ++_i) \
        __builtin_amdgcn_global_load_lds((const unsigned*)((const char*)(gbase) + (voff)[_i]), (PG8_LAS unsigned*)(lds + (bufoff) + ldsw + _i * 8192), 16, 0, 0); } while (0)
#define PG8_LDA(dst, b, h) do { _Pragma("unroll") for (int m = 0; m < 4; ++m) _Pragma("unroll") for (int k = 0; k < 2; ++k) dst[m][k] = *(const PG8_LAS bf16x8*)(lds + PG8_SA(b, h) + aoff + m * 2048 + k * 1024); } while (0)
#define PG8_LDB(dst, b, h) do { _Pragma("unroll") for (int n = 0; n < 2; ++n) _Pragma("unroll") for (int k = 0; k < 2; ++k) dst[n][k] = *(const PG8_LAS bf16x8*)(lds + PG8_SB(b, h) + boff + n * 2048 + k * 1024); } while (0)
#define PG8_MMA(ai, bj, At, Bt) do { __builtin_amdgcn_s_setprio(1); _Pragma("unroll") for (int m = 0; m < 4; ++m) _Pragma("unroll") for (int n = 0; n < 2; ++n) _Pragma("unroll") for (int k = 0; k < 2; ++k) \
        acc[ai][bj][m][n] = __builtin_amdgcn_mfma_f32_16x16x32_bf16(Bt[n][k], At[m][k], acc[ai][bj][m][n], 0, 0, 0); __builtin_amdgcn_s_setprio(0); } while (0)
#define PG8_WAIT_V(n) asm volatile("s_waitcnt vmcnt(" #n ")" ::: "memory")
#define PG8_WAIT_L(n) asm volatile("s_waitcnt lgkmcnt(" #n ")" ::: "memory")
#define PG8_BAR __builtin_amdgcn_s_barrier()
#define PG8_SCHED __builtin_amdgcn_sched_barrier(0)
    Unit cur, nxt; int ui = 0;
    if (!S.next(0, cur)) return;
    f32x4 acc[2][2][4][2];
#pragma unroll
    for (int a = 0; a < 2; ++a)
#pragma unroll
        for (int b = 0; b < 2; ++b)
#pragma unroll
            for (int m = 0; m < 4; ++m)
#pragma unroll
                for (int n = 0; n < 2; ++n) acc[a][b][m][n] = (f32x4){0.f, 0.f, 0.f, 0.f};
    bf16x8 At[4][2], B0[2][2], B1[2][2];
    const char* cA = (const char*)g.A + (size_t)cur.pm * tstep; const char* cB = (const char*)g.Bt + (size_t)cur.pn * tstepB;
    S.a_ready(cur);
    if constexpr (SP2) {
        PG8_STAGE(PG8_SB(0, 0), cB, voffB); PG8_STAGE(PG8_SB(0, 1), cB + hstepB, voffB); PG8_STAGE(PG8_SA(0, 0), cA, voffA); PG8_STAGE(PG8_SA(0, 1), cA + hstep, voffA);
        if (wr == 1) PG8_BAR;
        PG8_WAIT_V(2); PG8_BAR;
        PG8_STAGE(PG8_SB(1, 0), cB + kstep, voffB); PG8_STAGE(PG8_SA(1, 0), cA + kstep, voffA); PG8_STAGE(PG8_SB(1, 1), cB + hstepB + kstep, voffB);
        PG8_WAIT_V(6); PG8_BAR;
    } else {
        PG8_STAGE(PG8_SB(0, 0), cB, voffB); PG8_STAGE(PG8_SA(0, 0), cA, voffA); PG8_STAGE(PG8_SB(0, 1), cB + hstepB, voffB); PG8_STAGE(PG8_SA(0, 1), cA + hstep, voffA);
        if (wr == 1) PG8_BAR;
        PG8_WAIT_V(4); PG8_BAR;
        PG8_STAGE(PG8_SB(1, 0), cB + kstep, voffB); PG8_STAGE(PG8_SA(1, 0), cA + kstep, voffA); PG8_STAGE(PG8_SB(1, 1), cB + hstepB + kstep, voffB);
        PG8_WAIT_V(6); PG8_BAR;
    }
    for (;;) {
        const bool has_next = S.next(ui + 1, nxt);
        const char* nA = has_next ? (const char*)g.A + (size_t)nxt.pm * tstep : cA; const char* nB = has_next ? (const char*)g.Bt + (size_t)nxt.pn * tstepB : cB;
        for (int t = 0; t < nt; t += 2) {
            const bool last = (t == nt - 2);
            const char* a1 = cA + (size_t)(t + 1) * kstep;
            const char* a2 = last ? nA : cA + (size_t)(t + 2) * kstep; const char* b2 = last ? nB : cB + (size_t)(t + 2) * kstep;
            const char* a3 = a2 + kstep; const char* b3 = b2 + kstep;
            if (last && has_next) S.a_ready(nxt);
            if constexpr (SP2) {
            PG8_LDB(B0, 0, 0); PG8_LDB(B1, 0, 1); PG8_SCHED; PG8_LDA(At, 0, 0); PG8_STAGE(PG8_SA(1, 1), a1 + hstep, voffA);
            PG8_WAIT_V(8); PG8_WAIT_L(0); PG8_BAR; PG8_MMA(0, 0, At, B0); PG8_MMA(0, 1, At, B1); PG8_BAR; PG8_SCHED;
            PG8_LDA(At, 0, 1); PG8_STAGE(PG8_SB(0, 0), b2, voffB); PG8_STAGE(PG8_SB(0, 1), b2 + hstepB, voffB); PG8_STAGE(PG8_SA(0, 0), a2, voffA);
            PG8_WAIT_V(8); PG8_WAIT_L(0); PG8_BAR; PG8_MMA(1, 0, At, B0); PG8_MMA(1, 1, At, B1); PG8_BAR; PG8_SCHED;
            PG8_LDB(B0, 1, 0); PG8_LDB(B1, 1, 1); PG8_SCHED; PG8_LDA(At, 1, 0); PG8_STAGE(PG8_SA(0, 1), a2 + hstep, voffA);
            PG8_WAIT_V(8); PG8_WAIT_L(0); PG8_BAR; PG8_MMA(0, 0, At, B0); PG8_MMA(0, 1, At, B1); PG8_BAR; PG8_SCHED;
            PG8_LDA(At, 1, 1); PG8_STAGE(PG8_SB(1, 0), b3, voffB); PG8_STAGE(PG8_SB(1, 1), b3 + hstepB, voffB); PG8_STAGE(PG8_SA(1, 0), a3, voffA);
            PG8_WAIT_V(8); PG8_WAIT_L(0); PG8_BAR; PG8_MMA(1, 0, At, B0); PG8_MMA(1, 1, At, B1); PG8_BAR; PG8_SCHED;
            } else {
            PG8_LDB(B0, 0, 0); PG8_SCHED; PG8_LDA(At, 0, 0); PG8_STAGE(PG8_SA(1, 1), a1 + hstep, voffA);
            PG8_WAIT_L(8); PG8_BAR; PG8_WAIT_L(0); PG8_MMA(0, 0, At, B0); PG8_BAR; PG8_SCHED;
            PG8_LDB(B1, 0, 1); PG8_STAGE(PG8_SB(0, 0), b2, voffB);
            PG8_BAR; PG8_WAIT_L(0); PG8_MMA(0, 1, At, B1); PG8_BAR;
            PG8_LDA(At, 0, 1); PG8_STAGE(PG8_SA(0, 0), a2, voffA);
            PG8_BAR; PG8_WAIT_L(0); PG8_MMA(1, 0, At, B0); PG8_BAR; PG8_SCHED;
            PG8_STAGE(PG8_SB(0, 1), b2 + hstepB, voffB);
            PG8_WAIT_V(6); PG8_BAR; PG8_MMA(1, 1, At, B1); PG8_BAR;
            PG8_LDB(B0, 1, 0); PG8_SCHED; PG8_LDA(At, 1, 0); PG8_STAGE(PG8_SA(0, 1), a2 + hstep, voffA);
            PG8_WAIT_L(8); PG8_BAR; PG8_WAIT_L(0); PG8_MMA(0, 0, At, B0); PG8_BAR; PG8_SCHED;
            PG8_LDB(B1, 1, 1); PG8_STAGE(PG8_SB(1, 0), b3, voffB);
            PG8_BAR; PG8_WAIT_L(0); PG8_MMA(0, 1, At, B1); PG8_BAR;
            PG8_LDA(At, 1, 1); PG8_STAGE(PG8_SA(1, 0), a3, voffA);
            PG8_BAR; PG8_WAIT_L(0); PG8_MMA(1, 0, At, B0); PG8_BAR; PG8_SCHED;
            PG8_STAGE(PG8_SB(1, 1), b3 + hstepB, voffB);
            PG8_WAIT_V(6); PG8_BAR; PG8_MMA(1, 1, At, B1); PG8_BAR;
            }
        }
        if constexpr (ALIGN_EPI) { if (wr == 0) PG8_BAR; }
        if constexpr (!Epi::AFTER_DRAIN) { E(acc, cur, wr, wc, fr, fq); S.done(cur); }
        if (!has_next) break;
#pragma unroll
        for (int a = 0; a < 2; ++a)
#pragma unroll
            for (int b = 0; b < 2; ++b)
#pragma unroll
                for (int m = 0; m < 4; ++m)
#pragma unroll
                    for (int n = 0; n < 2; ++n) acc[a][b][m][n] = (f32x4){0.f, 0.f, 0.f, 0.f};
        cur = nxt; cA = nA; cB = nB; ++ui;
        if constexpr (ALIGN_EPI) { if (wr == 1) PG8_BAR; }
    }
    PG8_WAIT_V(0);
    if constexpr (!ALIGN_EPI) { if (wr == 0) PG8_BAR; }
    PG8_BAR;
    if constexpr (Epi::AFTER_DRAIN) { E.fused(acc, cur, wr, wc, fr, fq, lds, wid, lane); S.done(cur); }
#undef PG8_SA
#undef PG8_SB
#undef PG8_STAGE
#undef PG8_LDA
#undef PG8_LDB
#undef PG8_MMA
#undef PG8_WAIT_V
#undef PG8_WAIT_L
#undef PG8_BAR
#undef PG8_SCHED
}
}
namespace pg8 {
typedef unsigned u32x2 __attribute__((ext_vector_type(2)));
constexpr float RMS_EPS = 1e-6f;
typedef unsigned long long u64;
constexpr float SS_SCALE = 1048576.0f;
__device__ __forceinline__ float rstd_of(const u64* ss, int row) { return __builtin_amdgcn_rsqf((float)ss[row] * (1.0f / (2048.0f * SS_SCALE)) + RMS_EPS); }

constexpr int STG_ROW = 144, STG_WAVE = 16 * STG_ROW, STG_OFF = 131072, RSTD_OFF = STG_OFF + 8 * STG_WAVE;
constexpr size_t PLANE = (size_t)32768 * 128;
template <int LAYOUT> __device__ __forceinline__ void staged_store_bf16(PG8_LAS unsigned char* stg, bf16_t* O, size_t ldc, int rowg0, int pn, int wc, int lane) {
    const int p = lane & 7;
#pragma unroll
    for (int hr = 0; hr < 2; ++hr) { const int r = 8 * hr + (lane >> 3), rowg = rowg0 + r; const u32x4 w = *(const PG8_LAS u32x4*)(stg + r * STG_ROW + p * 16);
        if (LAYOUT == 0) __builtin_nontemporal_store(w, (u32x4*)(O + (size_t)rowg * ldc + pn * BM + wc * 64 + p * 8));
        else { const int P = 2 * pn + (wc >> 1); int drow = rowg;
            if (LAYOUT == 2) { const int sh = 2 * (P / 24), t = rowg & 16383; drow = (rowg & ~16383) + ((t & ((1 << sh) - 1)) << (14 - sh)) + (t >> sh); }
            __builtin_nontemporal_store(w, (u32x4*)(O + (size_t)P * PLANE + (size_t)drow * 128 + (wc & 1) * 64 + p * 8)); } }
}
template <int ACT, int LAYOUT> struct EpiRowScale {
    static constexpr bool PERM = true, AFTER_DRAIN = false;
    bf16_t* O; int ldc; const u64* ss; PG8_LAS unsigned char* lds;
    __device__ __forceinline__ void operator()(const f32x4 (&acc)[2][2][4][2], const Unit& u, int wr, int wc, int fr, int fq) const {
        const int lane = fr + 16 * fq; PG8_LAS unsigned char* stg = lds + STG_OFF + (wr * 4 + wc) * STG_WAVE;
        const PG8_LAS float* rtab = (const PG8_LAS float*)(lds + RSTD_OFF) + ((u.pm >> 3) & 3) * 256;
#pragma unroll
        for (int ai = 0; ai < 2; ++ai)
#pragma unroll
            for (int m = 0; m < 4; ++m) {
                const int rowg0 = u.pm * BM + ai * HALF + wr * 64 + m * 16; const float rs = rtab[ai * HALF + wr * 64 + m * 16 + fr];
#pragma unroll
                for (int bj = 0; bj < 2; ++bj) {
                    f32x4 v0 = acc[ai][bj][m][0] * rs, v1 = acc[ai][bj][m][1] * rs;
                    if (ACT == 1) { const f32x4 z = {0.f, 0.f, 0.f, 0.f}; v0 = __builtin_elementwise_max(v0, z); v1 = __builtin_elementwise_max(v1, z); v0 = v0 * v0; v1 = v1 * v1; }
                    u32x4 w; w.x = cvt_pk_bf16(v0[0], v0[1]); w.y = cvt_pk_bf16(v0[2], v0[3]); w.z = cvt_pk_bf16(v1[0], v1[1]); w.w = cvt_pk_bf16(v1[2], v1[3]);
                    *(PG8_LAS u32x4*)(stg + fr * STG_ROW + bj * 64 + fq * 16) = w; }
                staged_store_bf16<LAYOUT>(stg, O, (size_t)ldc, rowg0, u.pn, wc, lane);
            }
    }
};
struct EpiQkvRope {
    static constexpr bool PERM = false, AFTER_DRAIN = false;
    bf16_t* O; int ldc; const u64* ss; const float* cst; const float* snt; PG8_LAS unsigned char* lds;
    __device__ __forceinline__ void operator()(const f32x4 (&acc)[2][2][4][2], const Unit& u, int wr, int wc, int fr, int fq) const {
        const int lane = fr + 16 * fq; PG8_LAS unsigned char* stg = lds + STG_OFF + (wr * 4 + wc) * STG_WAVE;
        const bool rot = ((wc & 1) == 0) && (((u.pn >> 2) % 3) != 2);
        const PG8_LAS float* rtab = (const PG8_LAS float*)(lds + RSTD_OFF) + ((u.pm >> 3) & 3) * 256;
#pragma unroll
        for (int ai = 0; ai < 2; ++ai)
#pragma unroll
            for (int m = 0; m < 4; ++m) {
                const int rowg0 = u.pm * BM + ai * HALF + wr * 64 + m * 16, row = rowg0 + fr; const float rs = rtab[ai * HALF + wr * 64 + m * 16 + fr];
                f32x4 c4 = {1.f, 1.f, 1.f, 1.f}, s4 = {0.f, 0.f, 0.f, 0.f};
                if (rot) { const int t = row & 16383; c4 = *(const f32x4*)(cst + t * 16 + 4 * fq); s4 = *(const f32x4*)(snt + t * 16 + 4 * fq); }
#pragma unroll
                for (int bj = 0; bj < 2; ++bj) {
                    const f32x4 a = acc[ai][bj][m][0] * rs, b = acc[ai][bj][m][1] * rs;
                    const f32x4 a2 = (bj == 0) ? a * c4 - b * s4 : a, b2 = (bj == 0) ? b * c4 + a * s4 : b;
                    u32x2 w0, w1; w0.x = cvt_pk_bf16(a2[0], a2[1]); w0.y = cvt_pk_bf16(a2[2], a2[3]); w1.x = cvt_pk_bf16(b2[0], b2[1]); w1.y = cvt_pk_bf16(b2[2], b2[3]);
                    *(PG8_LAS u32x2*)(stg + fr * STG_ROW + bj * 64 + fq * 8) = w0; *(PG8_LAS u32x2*)(stg + fr * STG_ROW + bj * 64 + 32 + fq * 8) = w1; }
                staged_store_bf16<2>(stg, O, (size_t)ldc, rowg0, u.pn, wc, lane);
            }
    }
};
template <bool BASE_F32> struct EpiResid {
    static constexpr bool PERM = false, AFTER_DRAIN = false;
    const void* base; bf16_t* out; u64* ssn; PG8_LAS unsigned char* lds;
    __device__ __forceinline__ void operator()(const f32x4 (&acc)[2][2][4][2], const Unit& u, int wr, int wc, int fr, int fq) const {
        const int lane = fr + 16 * fq, r = lane >> 2, p = lane & 3; PG8_LAS unsigned char* stg = lds + STG_OFF + (wr * 4 + wc) * STG_WAVE;
#pragma unroll
        for (int ai = 0; ai < 2; ++ai)
#pragma unroll
            for (int m = 0; m < 4; ++m) {
                const int row = u.pm * BM + ai * HALF + wr * 64 + m * 16 + r; float q = 0.f;
#pragma unroll
                for (int bj = 0; bj < 2; ++bj) {
                    const size_t off = (size_t)row * 2048 + u.pn * BM + wc * 64 + bj * 32 + 8 * p;
                    f32x4 b0, b1;
                    if (BASE_F32) { b0 = *(const f32x4*)((const float*)base + off); b1 = *(const f32x4*)((const float*)base + off + 4); }
                    else { const u32x4 bb = *(const u32x4*)((const bf16_t*)base + off);
                        b0 = (f32x4){__uint_as_float(bb.x << 16), __uint_as_float(bb.x & 0xffff0000u), __uint_as_float(bb.y << 16), __uint_as_float(bb.y & 0xffff0000u)};
                        b1 = (f32x4){__uint_as_float(bb.z << 16), __uint_as_float(bb.z & 0xffff0000u), __uint_as_float(bb.w << 16), __uint_as_float(bb.w & 0xffff0000u)}; }
#pragma unroll
                    for (int n = 0; n < 2; ++n) *(PG8_LAS f32x4*)(stg + fr * STG_ROW + n * 64 + fq * 16) = acc[ai][bj][m][n];
                    const f32x4 v0 = *(const PG8_LAS f32x4*)(stg + r * STG_ROW + p * 32) + b0, v1 = *(const PG8_LAS f32x4*)(stg + r * STG_ROW + p * 32 + 16) + b1;
                    q += ((v0[0] * v0[0] + v0[1] * v0[1]) + (v0[2] * v0[2] + v0[3] * v0[3])) + ((v1[0] * v1[0] + v1[1] * v1[1]) + (v1[2] * v1[2] + v1[3] * v1[3]));
                    u32x4 w; w.x = cvt_pk_bf16(v0[0], v0[1]); w.y = cvt_pk_bf16(v0[2], v0[3]); w.z = cvt_pk_bf16(v1[0], v1[1]); w.w = cvt_pk_bf16(v1[2], v1[3]);
                    *(u32x4*)(out + off) = w;
                }
                q += __shfl_xor(q, 1); q += __shfl_xor(q, 2);
                if (p == 0) atomicAdd(ssn + row, (u64)(q * SS_SCALE));
            }
    }
};
}

namespace att {
typedef unsigned short bf16;
typedef short bf16x8 __attribute__((ext_vector_type(8)));
typedef short s16x4 __attribute__((ext_vector_type(4)));
typedef short v4i16_t __attribute__((ext_vector_type(4)));
typedef float f32x16 __attribute__((ext_vector_type(16)));
typedef float f32x4 __attribute__((ext_vector_type(4)));
typedef float f32x2_t __attribute__((ext_vector_type(2)));
typedef __bf16 bf16x2_t __attribute__((ext_vector_type(2)));
typedef unsigned u32x4 __attribute__((ext_vector_type(4)));
typedef unsigned u32x2 __attribute__((ext_vector_type(2)));
#define ALDS __attribute__((address_space(3)))
typedef ALDS unsigned char* ldsp;
constexpr float NEGBIG = -1e30f, LOG2E = 1.4426950408889634f;
__device__ __forceinline__ unsigned cvtpk(float lo, float hi) { f32x2_t v = {lo, hi}; bf16x2_t b = __builtin_convertvector(v, bf16x2_t); return __builtin_bit_cast(unsigned, b); }
__device__ __forceinline__ s16x4 vtr(ALDS const unsigned char* p) { return __builtin_bit_cast(s16x4, __builtin_amdgcn_ds_read_tr16_b64_v4i16((ALDS v4i16_t*)p)); }
__device__ __forceinline__ float bf2f(unsigned short b) { return __uint_as_float((unsigned)b << 16); }
__device__ __forceinline__ unsigned voff(int row, int ch) { return 256u * (unsigned)row + 16u * (unsigned)(ch ^ (((row & 3) << 2) | ((row >> 2) & 3))); }

struct St { f32x16 O[4]; float m, l; };

__device__ __forceinline__ void softmax_pv(f32x16& st, const unsigned (&trB)[2], St& S) {
    float mx = st[0];
#pragma unroll
    for (int i = 1; i < 16; ++i) mx = fmaxf(mx, st[i]);
    mx = fmaxf(mx, __shfl_xor(mx, 32));
    const float mn = fmaxf(S.m, mx), alpha = __builtin_amdgcn_exp2f(S.m - mn);
    float rs = 0.f;
#pragma unroll
    for (int i = 0; i < 16; ++i) { st[i] = __builtin_amdgcn_exp2f(st[i] - mn); rs += st[i]; }
    rs += __shfl_xor(rs, 32);
    S.l = S.l * alpha + rs;
    if (__builtin_amdgcn_ballot_w64(mn > S.m) != 0ull) {
#pragma unroll
        for (int db = 0; db < 4; ++db)
#pragma unroll
            for (int i = 0; i < 16; ++i) S.O[db][i] *= alpha;
    }
    S.m = mn;
    asm volatile("" ::: "memory");
    unsigned tb0 = trB[0], tb1 = trB[1]; asm volatile("" : "+v"(tb0), "+v"(tb1));
#pragma unroll
    for (int s = 0; s < 2; ++s) {
        u32x4 pw; pw.x = cvtpk(st[8 * s + 0], st[8 * s + 1]); pw.y = cvtpk(st[8 * s + 2], st[8 * s + 3]); pw.z = cvtpk(st[8 * s + 4], st[8 * s + 5]); pw.w = cvtpk(st[8 * s + 6], st[8 * s + 7]);
        const bf16x8 pf = __builtin_bit_cast(bf16x8, pw);
#pragma unroll
        for (int db = 0; db < 4; ++db) {
            const s16x4 a0 = vtr((ALDS const unsigned char*)((tb0 ^ (unsigned)(db << 6)) + 4096u * s)), a1 = vtr((ALDS const unsigned char*)((tb1 ^ (unsigned)(db << 6)) + 4096u * s));
            const bf16x8 vf = {a0[0], a0[1], a0[2], a0[3], a1[0], a1[1], a1[2], a1[3]};
            S.O[db] = __builtin_amdgcn_mfma_f32_32x32x16_bf16(vf, pf, S.O[db], 0, 0, 0);
        }
    }
    asm volatile("" ::: "memory");
}
__device__ __forceinline__ void softmax_pv2(f32x16& s0, f32x16& s1, const unsigned (&trA)[2], const unsigned (&trB)[2], St& S) {
    float mx = fmaxf(s0[0], s1[0]);
#pragma unroll
    for (int i = 1; i < 16; ++i) mx = fmaxf(mx, fmaxf(s0[i], s1[i]));
    mx = fmaxf(mx, __shfl_xor(mx, 32));
    const float mn = fmaxf(S.m, mx), alpha = __builtin_amdgcn_exp2f(S.m - mn);
    float rs = 0.f;
#pragma unroll
    for (int i = 0; i < 16; ++i) { s0[i] = __builtin_amdgcn_exp2f(s0[i] - mn); s1[i] = __builtin_amdgcn_exp2f(s1[i] - mn); rs += s0[i] + s1[i]; }
    rs += __shfl_xor(rs, 32);
    S.l = S.l * alpha + rs;
    if (__builtin_amdgcn_ballot_w64(mn > S.m) != 0ull) {
#pragma unroll
        for (int db = 0; db < 4; ++db)
#pragma unroll
            for (int i = 0; i < 16; ++i) S.O[db][i] *= alpha;
    }
    S.m = mn;
    asm volatile("" ::: "memory");
    unsigned a0 = trA[0], a1 = trA[1], b0 = trB[0], b1 = trB[1]; asm volatile("" : "+v"(a0), "+v"(a1), "+v"(b0), "+v"(b1));
#pragma unroll
    for (int tl = 0; tl < 2; ++tl)
#pragma unroll
    for (int s = 0; s < 2; ++s) {
        const f32x16& st = tl ? s1 : s0; const unsigned t0 = tl ? b0 : a0, t1 = tl ? b1 : a1;
        u32x4 pw; pw.x = cvtpk(st[8 * s + 0], st[8 * s + 1]); pw.y = cvtpk(st[8 * s + 2], st[8 * s + 3]); pw.z = cvtpk(st[8 * s + 4], st[8 * s + 5]); pw.w = cvtpk(st[8 * s + 6], st[8 * s + 7]);
        const bf16x8 pf = __builtin_bit_cast(bf16x8, pw);
#pragma unroll
        for (int db = 0; db < 4; ++db) {
            const s16x4 v0 = vtr((ALDS const unsigned char*)((t0 ^ (unsigned)(db << 6)) + 4096u * s)), v1 = vtr((ALDS const unsigned char*)((t1 ^ (unsigned)(db << 6)) + 4096u * s));
            const bf16x8 vf = {v0[0], v0[1], v0[2], v0[3], v1[0], v1[1], v1[2], v1[3]};
            S.O[db] = __builtin_amdgcn_mfma_f32_32x32x16_bf16(vf, pf, S.O[db], 0, 0, 0);
        }
    }
    asm volatile("" ::: "memory");
}
#define ATT_BASES(ldsbase) \
    const unsigned klb = (ldsbase) + (unsigned)(wave * 16384), vlb = klb + 8192u; const int lq = lane >> 4, chn = lane & 15; \
    const unsigned kC = klb + (unsigned)(r32 * 256 + (((r32 & 15) ^ hh) << 4)); \
    const unsigned kD = klb + (unsigned)(lq * 256 + ((chn ^ lq) << 4)); \
    const unsigned vE = vlb + (unsigned)(lq * 256 + ((chn ^ (lq << 2)) << 4)); \
    const unsigned oW = klb + (unsigned)(r32 * 256 + ((r32 & 15) << 4) + 8 * hh);     \
    unsigned trB[2]; { const int g_ = (lane >> 4) & 1, q_ = (lane & 15) >> 2, p_ = lane & 3; \
        _Pragma("unroll") for (int u = 0; u < 2; ++u) trB[u] = vlb + voff(8 * u + 4 * hh + q_, 2 * g_ + (p_ >> 1)) + 8u * (unsigned)(p_ & 1); }
#define ATT_Q_DMA() do { unsigned qo_ = kD - klb; asm volatile("" : "+v"(qo_) :: "memory");     \
        _Pragma("unroll") for (int c = 0; c < 8; ++c) \
        __builtin_amdgcn_global_load_lds((const unsigned*)(qb + 1024 * c + (qo_ ^ (unsigned)((c & 3) << 6))), (ALDS unsigned*)(klb + 1024u * c), 16, 0, 0); } while (0)
#define ATT_Q_FRAGS() do { asm volatile("s_waitcnt vmcnt(16)" ::: "memory"); \
        { unsigned kC_ = kC; asm volatile("" : "+v"(kC_)); _Pragma("unroll") for (int d0 = 0; d0 < 8; ++d0) qf[d0] = *(const ALDS bf16x8*)(kC_ ^ (unsigned)(d0 << 5)); } \
        asm volatile("s_waitcnt lgkmcnt(0)" : "+v"(qf[0]), "+v"(qf[1]), "+v"(qf[2]), "+v"(qf[3]), "+v"(qf[4]), "+v"(qf[5]), "+v"(qf[6]), "+v"(qf[7]) :: "memory"); } while (0)
#define ATT_STAGE_K() do { unsigned kD_ = kD; asm volatile("" : "+v"(kD_));     \
        _Pragma("unroll") for (int c = 0; c < 8; ++c) *(ALDS u32x4*)((kD_ ^ (unsigned)((c & 3) << 6)) + 1024u * c) = kr[c]; asm volatile("" ::: "memory"); } while (0)
#define ATT_STAGE_V() do { unsigned vE_ = vE; asm volatile("" : "+v"(vE_)); asm volatile("" ::: "memory"); \
        _Pragma("unroll") for (int c = 0; c < 8; ++c) *(ALDS u32x4*)((vE_ ^ (unsigned)((c & 3) << 4)) + 1024u * c) = vr[c]; asm volatile("" ::: "memory"); } while (0)
#define ATT_QK() do { bf16x8 kf_[8]; unsigned kC_ = kC; asm volatile("" : "+v"(kC_)); _Pragma("unroll") for (int d0 = 0; d0 < 8; ++d0) kf_[d0] = *(const ALDS bf16x8*)(kC_ ^ (unsigned)(d0 << 5)); \
        asm volatile("s_waitcnt lgkmcnt(0)" : "+v"(kf_[0]), "+v"(kf_[1]), "+v"(kf_[2]), "+v"(kf_[3]), "+v"(kf_[4]), "+v"(kf_[5]), "+v"(kf_[6]), "+v"(kf_[7]) :: "memory"); \
        st = (f32x16){0.f,0.f,0.f,0.f,0.f,0.f,0.f,0.f,0.f,0.f,0.f,0.f,0.f,0.f,0.f,0.f}; \
        _Pragma("unroll") for (int d0 = 0; d0 < 8; ++d0) st = __builtin_amdgcn_mfma_f32_32x32x16_bf16(kf_[d0], qf[d0], st, 0, 0, 0); } while (0)

__device__ __forceinline__ void na_phase(const bf16* qkv, bf16* out, const float* rpb, ldsp lds, int vcu, int G, int tid_in) {
    int tid_ = tid_in; asm volatile("" : "+v"(tid_)); const int tid = tid_, lane = tid & 63, wave = __builtin_amdgcn_readfirstlane(tid >> 6), r32 = lane & 31, hh = lane >> 5;
    ALDS float* tb = (ALDS float*)(lds + 131072);
    for (int i = tid; i < 16 * 465; i += 512) tb[i] = rpb[i] * LOG2E;
    __syncthreads();
    constexpr size_t PITCH = 128, PLANE = pg8::PLANE; constexpr int NUNITS = 2048;
    const int per = (NUNITS + G - 1) / G; const int u_lo = vcu * per, u_hi = (u_lo + per < NUNITS) ? u_lo + per : NUNITS;
    const int w4 = wave & 3, lq = lane >> 4, chn = lane & 15;
    const unsigned sb = (unsigned)(unsigned long)lds + (unsigned)(w4 * 32768);
    const int ntot = (u_hi - u_lo) * 20;
#define NA_GEOM(it_) const int U_ = u_lo + ((it_) >> 1), j = (it_) & 1; int bh_, rq_; \
        if (G == 256) { const int x_ = vcu >> 5, c_ = vcu & 31, i_ = U_ - u_lo; bh_ = x_ * 4 + (i_ >> 1); rq_ = (i_ & 1) * 32 + c_; } else { bh_ = U_ >> 6; rq_ = U_ & 63; } \
        const int b = bh_ >> 4, h = bh_ & 15, row = 4 * rq_ + w4, tokb = b * 16384, rs = min(max(row - 4, 0), 248);
    if (wave >= 4) {
        const unsigned lane_off = (unsigned)(lq * (int)(PITCH * 2) + chn * 16);
        const unsigned kDl = (unsigned)(lq * 256 + ((chn ^ lq) << 4)), vEl = (unsigned)(lq * 256 + ((chn ^ (lq << 2)) << 4));
        u32x4 kr[16], vr[16];
#define NAL_LOAD(n_, o_) do { const int it_ = (n_) / 10, t_ = (n_) - 10 * it_; NA_GEOM(it_) \
            const char* kb_ = (const char*)(qkv + (size_t)(16 + h) * PLANE); const char* vb_ = (const char*)(qkv + (size_t)(32 + h) * PLANE); \
            const int rg_ = t_ / 5, cb_ = t_ - 5 * rg_, kr0_ = rs + 4 * rg_, kc0_ = 8 * (cb_ + 3 * j); \
            _Pragma("unroll") for (int c = 0; c < 8; ++c) { const int uo_ = (tokb + (kr0_ + (c >> 1)) * 64 + kc0_ + 4 * (c & 1)) * (int)(PITCH * 2); \
                kr[(o_) + c] = *(const u32x4*)((kb_ + (long)uo_) + lane_off); vr[(o_) + c] = *(const u32x4*)((vb_ + (long)uo_) + lane_off); } } while (0)
        if (ntot > 0) { NAL_LOAD(0, 0); NAL_LOAD(1, 8); }
#pragma unroll 1
        for (int n = 0; n < ntot; n += 2) {
#pragma unroll
            for (int tl = 0; tl < 2; ++tl) { unsigned kD_ = sb + (unsigned)(tl * 16384) + kDl, vE_ = sb + (unsigned)(tl * 16384) + 8192u + vEl; asm volatile("" : "+v"(kD_), "+v"(vE_));
#pragma unroll
              for (int c = 0; c < 8; ++c) { *(ALDS u32x4*)((kD_ ^ (unsigned)((c & 3) << 6)) + 1024u * c) = kr[8 * tl + c]; *(ALDS u32x4*)((vE_ ^ (unsigned)((c & 3) << 4)) + 1024u * c) = vr[8 * tl + c]; } }
            asm volatile("s_waitcnt lgkmcnt(0)" ::: "memory"); __builtin_amdgcn_s_barrier(); asm volatile("" ::: "memory");
            if (n + 2 < ntot) { NAL_LOAD(n + 2, 0); NAL_LOAD(n + 3, 8); }
            asm volatile("" ::: "memory"); __builtin_amdgcn_s_barrier(); asm volatile("" ::: "memory");
        }
#undef NAL_LOAD
        return;
    }
    const unsigned kCl = (unsigned)(r32 * 256 + (((r32 & 15) ^ hh) << 4));
    const unsigned oWl = (unsigned)(r32 * 256 + ((r32 & 15) << 4) + 8 * hh);
    unsigned trl[2]; { const int g_ = (lane >> 4) & 1, q_ = (lane & 15) >> 2, p_ = lane & 3;
#pragma unroll
        for (int u = 0; u < 2; ++u) trl[u] = voff(8 * u + 4 * hh + q_, 2 * g_ + (p_ >> 1)) + 8u * (unsigned)(p_ & 1); }
    const int nitems = (u_hi - u_lo) * 2;
#pragma unroll 1
    for (int it = 0; it < nitems; ++it) {
        NA_GEOM(it)
        const int qc = 32 * j + r32, cs = min(max(qc - 8, 0), 48);
        const ALDS float* tbh = tb + h * 465;
        const bf16* qp = qkv + (size_t)h * PLANE + (size_t)(tokb + row * 64 + qc) * PITCH + 8 * hh;
        bf16x8 qf[8];
#pragma unroll
        for (int d0 = 0; d0 < 8; ++d0) qf[d0] = *(const bf16x8*)(qp + 16 * d0);
        St S; S.m = NEGBIG; S.l = 0.f;
#pragma unroll
        for (int db = 0; db < 4; ++db)
#pragma unroll
            for (int i = 0; i < 16; ++i) S.O[db][i] = 0.f;
        f32x16 st0, st1;
#define NAC_QK(ST, SLOT) do { bf16x8 kf_[8]; unsigned kC_ = (SLOT) + kCl; asm volatile("" : "+v"(kC_)); \
            _Pragma("unroll") for (int d0 = 0; d0 < 8; ++d0) kf_[d0] = *(const ALDS bf16x8*)(kC_ ^ (unsigned)(d0 << 5)); \
            asm volatile("s_waitcnt lgkmcnt(0)" : "+v"(kf_[0]), "+v"(kf_[1]), "+v"(kf_[2]), "+v"(kf_[3]), "+v"(kf_[4]), "+v"(kf_[5]), "+v"(kf_[6]), "+v"(kf_[7]) :: "memory"); \
            ST = (f32x16){0.f,0.f,0.f,0.f,0.f,0.f,0.f,0.f,0.f,0.f,0.f,0.f,0.f,0.f,0.f,0.f}; \
            _Pragma("unroll") for (int d0 = 0; d0 < 8; ++d0) ST = __builtin_amdgcn_mfma_f32_32x32x16_bf16(kf_[d0], qf[d0], ST, 0, 0, 0); } while (0)
#define NAC_MASK(ST, TT) do { const int t_ = (TT); const int rg = t_ / 5, cb = t_ - 5 * rg, kr0 = rs + 4 * rg, kc0 = 8 * (cb + 3 * j); const int drb = kr0 - row + 7, kcb = kc0 + 4 * hh; \
            _Pragma("unroll") for (int hf = 0; hf < 4; ++hf) { float bvv[4]; \
                _Pragma("unroll") for (int e = 0; e < 4; ++e) { const int dc = min(max(kcb + e - qc + 15, 0), 30); bvv[e] = tbh[(drb + hf) * 31 + dc]; } \
                asm volatile("" : "+v"(bvv[0]), "+v"(bvv[1]), "+v"(bvv[2]), "+v"(bvv[3])); \
                _Pragma("unroll") for (int e = 0; e < 4; ++e) { const int i = 4 * hf + e; ST[i] = ((unsigned)(kcb + e - cs) < 16u) ? ST[i] + bvv[e] : NEGBIG; } } } while (0)
        const float inv_dummy = 0.f; (void)inv_dummy;
#pragma unroll 1
        for (int p2 = 0; p2 < 5; ++p2) {
            asm volatile("" ::: "memory"); __builtin_amdgcn_s_barrier(); asm volatile("" ::: "memory");
            NAC_QK(st0, sb); NAC_QK(st1, sb + 16384u);
            NAC_MASK(st0, 2 * p2); NAC_MASK(st1, 2 * p2 + 1);
            const unsigned trA[2] = {sb + 8192u + trl[0], sb + 8192u + trl[1]}, trBB[2] = {sb + 16384u + 8192u + trl[0], sb + 16384u + 8192u + trl[1]};
            softmax_pv2(st0, st1, trA, trBB, S);
            if (p2 < 4) { asm volatile("s_waitcnt lgkmcnt(0)" ::: "memory"); __builtin_amdgcn_s_barrier(); asm volatile("" ::: "memory"); }
        }
#undef NAC_QK
#undef NAC_MASK
        const float inv = 1.0f / S.l; const unsigned ob = sb + 16384u;
        { unsigned oW_ = ob + oWl; asm volatile("" : "+v"(oW_) :: "memory");
#pragma unroll
          for (int db = 0; db < 4; ++db)
#pragma unroll
            for (int g4 = 0; g4 < 4; ++g4) {
                u32x2 w; w.x = cvtpk(S.O[db][4 * g4] * inv, S.O[db][4 * g4 + 1] * inv); w.y = cvtpk(S.O[db][4 * g4 + 2] * inv, S.O[db][4 * g4 + 3] * inv);
                *(ALDS u32x2*)(oW_ ^ (unsigned)((4 * db + g4) << 4)) = w; } }
        asm volatile("" ::: "memory");
#pragma unroll
        for (int c = 0; c < 8; ++c) { const int qrow = 4 * c + lq, chunk = (chn ^ lq) ^ ((c & 3) << 2);
            const u32x4 w = *(const ALDS u32x4*)(ob + 16u * (unsigned)lane + 1024u * c);
            *(u32x4*)(out + (size_t)(tokb + row * 64 + 32 * j + qrow) * 2048 + h * 128 + chunk * 8) = w; }
        asm volatile("s_waitcnt lgkmcnt(0)" ::: "memory"); __builtin_amdgcn_s_barrier(); asm volatile("" ::: "memory");
    }
#undef NA_GEOM
}

__device__ __forceinline__ void dil_phase(const bf16* qkv, bf16* scratch, bf16* merged, ldsp lds, int vcu, int G, int tid_in) {
    int tid_ = tid_in; asm volatile("" : "+v"(tid_)); const int tid = tid_, lane = tid & 63, wave = __builtin_amdgcn_readfirstlane(tid >> 6), r32 = lane & 31, hh = lane >> 5;
    ATT_BASES((unsigned)(unsigned long)lds); ALDS float* lse = (ALDS float*)(lds + 131072);
    constexpr size_t PITCH = 128, PLANE = pg8::PLANE; constexpr int NUNITS = 512;
    const int per = (NUNITS + G - 1) / G; const int u_lo = vcu * per, u_hi = (u_lo + per < NUNITS) ? u_lo + per : NUNITS;
    for (int U = u_lo; U < u_hi; ++U) {
        const int b = U >> 8, head = (U >> 5) & 7, T0 = 512 * (U & 31), tokb = b * 16384;
#pragma unroll 1
        for (int k = 0; k < 6; ++k) {
            const int it = k * 8 + wave, g = it >> 4, sub = it & 15;
            const int shift = 2 * g, L = 16384 >> shift;
            const int r = (g == 0) ? 0 : (g == 1) ? (sub & 3) : sub;
            const int m0 = (g == 0) ? (T0 + 32 * sub) : (g == 1) ? ((T0 >> 2) + 32 * (sub >> 2)) : (T0 >> 4);
            const int mq = m0 + r32, tq = (mq << shift) + r;
            const int rbase = tokb + (r << (14 - shift));
            const char* qb = (const char*)(qkv + (size_t)((g * 3 + 0) * 8 + head) * PLANE + (size_t)(rbase + m0) * PITCH);
            ATT_Q_DMA();
            const char* kb = (const char*)(qkv + (size_t)((g * 3 + 1) * 8 + head) * PLANE); const char* vb = (const char*)(qkv + (size_t)((g * 3 + 2) * 8 + head) * PLANE);
            const unsigned lane_off = (unsigned)((lane >> 4) * (int)(PITCH * 2) + (lane & 15) * 16);
            St S; S.m = NEGBIG; S.l = 0.f;
#pragma unroll
            for (int db = 0; db < 4; ++db)
#pragma unroll
                for (int i = 0; i < 16; ++i) S.O[db][i] = 0.f;
            u32x4 kr[8], vr[8]; f32x16 st;
#define DIL_LOAD(t, dst, src) do { const int mk0_ = m0 - 64 + 32 * (t); \
            _Pragma("unroll") for (int c = 0; c < 8; ++c) { const int uo_ = (rbase + mk0_ + 4 * c) * (int)(PITCH * 2); dst[c] = *(const u32x4*)((src + (long)uo_) + lane_off); } } while (0)
            DIL_LOAD(0, kr, kb); DIL_LOAD(0, vr, vb);
            bf16x8 qf[8];
            ATT_Q_FRAGS();
#pragma unroll 1
            for (int t = 0; t < 5; ++t) {
                ATT_STAGE_K();
                ATT_QK();
                if (t + 1 < 5) DIL_LOAD(t + 1, kr, kb);
                const int mkb = m0 - 64 + 32 * t + 4 * hh;
#pragma unroll
                for (int i = 0; i < 16; ++i) {
                    const int mk = mkb + (i & 3) + 8 * (i >> 2), dd = mk - mq;
                    st[i] = ((unsigned)mk < (unsigned)L && dd <= 64 && dd >= -64) ? st[i] : NEGBIG;
                }
                ATT_STAGE_V();
                if (t + 1 < 5) DIL_LOAD(t + 1, vr, vb);
                softmax_pv(st, trB, S);
            }
#undef DIL_LOAD
            const float inv = 1.0f / S.l; const int tib = tq - T0;
            asm volatile("" ::: "memory");
#pragma unroll
            for (int db = 0; db < 4; ++db)
#pragma unroll
                for (int g4 = 0; g4 < 4; ++g4) {
                    u32x2 w; w.x = cvtpk(S.O[db][4 * g4] * inv, S.O[db][4 * g4 + 1] * inv); w.y = cvtpk(S.O[db][4 * g4 + 2] * inv, S.O[db][4 * g4 + 3] * inv);
                    *(ALDS u32x2*)(oW ^ (unsigned)((4 * db + g4) << 4)) = w; }
            asm volatile("" ::: "memory");
#pragma unroll
            for (int c = 0; c < 8; ++c) { const int qrow = 4 * c + lq, chunk = (chn ^ lq) ^ ((c & 3) << 2);
                const u32x4 w = *(const ALDS u32x4*)(klb + 16u * (unsigned)lane + 1024u * c);
                *(u32x4*)(scratch + (size_t)(g * 512 + (((m0 + qrow) << shift) + r - T0)) * 128 + chunk * 8) = w; }
            asm volatile("" ::: "memory");
            if (hh == 0) lse[g * 512 + tib] = S.m + __builtin_amdgcn_logf(S.l);
        }
        asm volatile("s_waitcnt vmcnt(0) lgkmcnt(0)" ::: "memory");
        __syncthreads();
        __builtin_amdgcn_fence(__ATOMIC_ACQUIRE, "workgroup");
        {
            int t2_ = tid; asm volatile("" : "+v"(t2_));
            const int ch = t2_ & 15, tg = t2_ >> 4;
#pragma unroll 4
            for (int ps = 0; ps < 16; ++ps) {
                const int tok = ps * 32 + tg;
                const float l0 = lse[tok], l1 = lse[512 + tok], l2 = lse[1024 + tok];
                const float mx = fmaxf(l0, fmaxf(l1, l2));
                float w0 = __builtin_amdgcn_exp2f(l0 - mx), w1 = __builtin_amdgcn_exp2f(l1 - mx), w2 = __builtin_amdgcn_exp2f(l2 - mx);
                const float iw = 1.0f / (w0 + w1 + w2); w0 *= iw; w1 *= iw; w2 *= iw;
                const u32x4 a0 = *(const u32x4*)(scratch + (size_t)(tok) * 128 + ch * 8), a1 = *(const u32x4*)(scratch + (size_t)(512 + tok) * 128 + ch * 8), a2 = *(const u32x4*)(scratch + (size_t)(1024 + tok) * 128 + ch * 8);
                u32x4 o;
#pragma unroll
                for (int e = 0; e < 4; ++e) {
                    const float lo = w0 * __uint_as_float(a0[e] << 16) + w1 * __uint_as_float(a1[e] << 16) + w2 * __uint_as_float(a2[e] << 16);
                    const float hi = w0 * __uint_as_float(a0[e] & 0xffff0000u) + w1 * __uint_as_float(a1[e] & 0xffff0000u) + w2 * __uint_as_float(a2[e] & 0xffff0000u);
                    o[e] = cvtpk(lo, hi); }
                *(u32x4*)(merged + (size_t)(tokb + T0 + tok) * 1024 + head * 128 + ch * 8) = o;
            }
        }
        asm volatile("s_waitcnt vmcnt(0) lgkmcnt(0)" ::: "memory");
        __syncthreads();
    }
}
}

constexpr int NWAVES = 8;
constexpr int LDH = 8192 + 64;
constexpr int TOK = 32768, SEQ = 16384, DM = 2048, DFF = 8192, NQKV0 = 6144, NQKV1 = 9216;
constexpr size_t MiB = 1u << 20;
constexpr size_t WS_SS = 0;
constexpr size_t WS_BAR = 3 * MiB / 2;
constexpr size_t WS_COS = 2 * MiB, WS_SIN = 3 * MiB;
constexpr size_t WS_WQKV0 = 4 * MiB, WS_WO0 = 28 * MiB, WS_W10 = 36 * MiB, WS_W20 = 68 * MiB;
constexpr size_t WS_WO1 = 4 * MiB, WS_W11 = 8 * MiB, WS_W21 = 40 * MiB;
constexpr size_t WS_WQKV1 = 100 * MiB;
constexpr size_t WS_XA = 136 * MiB, WS_XB = 264 * MiB;
constexpr size_t WS_BIG = 392 * MiB;
constexpr size_t WS_END = 968 * MiB;
constexpr int LDS_BYTES = 131072 + 29760 + 64;
constexpr int BARST_OFF = 131072 + 29760;

#define GAS __attribute__((address_space(1)))
#define LAS __attribute__((address_space(3)))
typedef unsigned short bf16;
typedef unsigned v4u __attribute__((ext_vector_type(4)));
typedef unsigned v2u __attribute__((ext_vector_type(2)));
typedef float f32x4 __attribute__((ext_vector_type(4)));
#define LDS_WAIT() asm volatile("s_waitcnt lgkmcnt(0)" ::: "memory")

__device__ __forceinline__ float wave_sum(float v) {
#pragma unroll
    for (int o = 1; o < 64; o <<= 1) v += __shfl_xor(v, o);
    return v;
}
__device__ __forceinline__ void tr_load(const float* W, int N, int nblk, int item, int lane, f32x4 (&wv)[8]) {
    const int kb = item / nblk, nb = item % nblk, k0 = 64 * kb, n0 = 32 * nb;
#pragma unroll
    for (int i = 0; i < 8; ++i) wv[i] = *(const f32x4*)(W + (size_t)(k0 + 8 * i + (lane >> 3)) * N + n0 + 4 * (lane & 7));
}
__device__ __forceinline__ void tr_stage(const float* gain, int nblk, int item, int lane, const f32x4 (&wv)[8], LAS float* scr) {
    const int k0 = 64 * (item / nblk);
#pragma unroll
    for (int i = 0; i < 8; ++i) { const int kk = 8 * i + (lane >> 3); const float gk = gain ? gain[k0 + kk] : 1.0f; LAS float* d = scr + kk * 33 + 4 * (lane & 7);
        d[0] = wv[i][0] * gk; d[1] = wv[i][1] * gk; d[2] = wv[i][2] * gk; d[3] = wv[i][3] * gk; }
    LDS_WAIT(); asm volatile("" ::: "memory");
}
__device__ __forceinline__ void tr_emit(int K, int nblk, bf16* WT, int qmode, float qs, LAS float* scr, int item, int lane) {
    const int kb = item / nblk, nb = item % nblk, k0 = 64 * kb, n0 = 32 * nb, c = lane & 7;
#pragma unroll
    for (int j = 0; j < 4; ++j) { const int n = (lane >> 3) + 8 * j, ncol = n0 + n; const LAS float* s = scr + (8 * c) * 33 + n;
        float sc = 1.0f; if (qmode == 1 && ncol < 2048) sc = qs; if (qmode == 2 && ((ncol >> 10) % 3) == 0) sc = qs;
        v4u o; o.x = pg8::cvt_pk_bf16(s[0 * 33] * sc, s[1 * 33] * sc); o.y = pg8::cvt_pk_bf16(s[2 * 33] * sc, s[3 * 33] * sc); o.z = pg8::cvt_pk_bf16(s[4 * 33] * sc, s[5 * 33] * sc); o.w = pg8::cvt_pk_bf16(s[6 * 33] * sc, s[7 * 33] * sc);
        *(v4u*)(WT + (size_t)ncol * K + k0 + 8 * c) = o; }
    LDS_WAIT(); asm volatile("" ::: "memory");
}
__device__ __forceinline__ void convert_matrix(const float* W, int K, int N, bf16* WT, const float* gain, int qmode, float qs, LAS float* scr, int gw, int NGW, int lane) {
    const int nblk = N / 32, nitems = (K / 64) * nblk;
    int it = gw; if (it >= nitems) return;
    f32x4 wv[8]; tr_load(W, N, nblk, it, lane, wv);
    for (;;) {
        tr_stage(gain, nblk, it, lane, wv, scr);
        const int nx = it + NGW; const bool more = nx < nitems;
        if (more) tr_load(W, N, nblk, nx, lane, wv);
        tr_emit(K, nblk, WT, qmode, qs, scr, it, lane);
        if (!more) break;
        it = nx;
    }
}
__device__ __forceinline__ void sincos_d(double a, float& so, float& co) {
    const double k = __builtin_rint(a * 0.63661977236758134308);
    double r = __builtin_fma(-k, 1.57079632679489655800e+00, a); r = __builtin_fma(-k, 6.12323399573676603587e-17, r);
    const double r2 = r * r;
    double sp = 1.0 / 6227020800.0; sp = sp * r2 - 1.0 / 39916800.0; sp = sp * r2 + 1.0 / 362880.0; sp = sp * r2 - 1.0 / 5040.0; sp = sp * r2 + 1.0 / 120.0; sp = sp * r2 - 1.0 / 6.0; sp = sp * r2 * r + r;
    double cp = -1.0 / 87178291200.0; cp = cp * r2 + 1.0 / 479001600.0; cp = cp * r2 - 1.0 / 3628800.0; cp = cp * r2 + 1.0 / 40320.0; cp = cp * r2 - 1.0 / 720.0; cp = cp * r2 + 1.0 / 24.0; cp = cp * r2 - 0.5; cp = cp * r2 + 1.0;
    const int q = ((int)k) & 3;
    double ss = (q & 1) ? cp : sp, cc = (q & 1) ? sp : cp;
    if (q == 1) cc = -cc; else if (q == 2) { ss = -ss; cc = -cc; } else if (q == 3) ss = -ss;
    so = (float)ss; co = (float)cc;
}

__device__ __forceinline__ void fill_rstd(LAS unsigned char* L, const pg8::StaticOrder& S, const pg8::u64* ssx, int tid) {
    LAS float* tabl = (LAS float*)(L + pg8::RSTD_OFF); pg8::Unit u; int last = -1;
    for (int i = 0; S.next(i, u); ++i) { if (u.pm != last) { last = u.pm; if (tid < 256) tabl[((u.pm >> 3) & 3) * 256 + tid] = pg8::rstd_of(ssx, u.pm * 256 + tid); } }
    __syncthreads();
}
#define XB_TMO      128
#define XB_XCNT(j)  (256  + 64 * (j))
#define XB_XSUB(j)  (1280 + 64 * (j))
#define XB_XGEN(j)  (2304 + 64 * (j))
#define XB_TOP      3328
#define XB_TOPGEN   3392
#define XCD_BAR_WORDS 3456
#define XB_SPIN_CAP (1u << 18)

__device__ __forceinline__ unsigned xb_ld(unsigned* p)              { return __hip_atomic_load(p, __ATOMIC_RELAXED, __HIP_MEMORY_SCOPE_AGENT); }
__device__ __forceinline__ unsigned xb_add(unsigned* p, unsigned v) { return __hip_atomic_fetch_add(p, v, __ATOMIC_RELAXED, __HIP_MEMORY_SCOPE_AGENT); }
__device__ __forceinline__ unsigned xb_xcc_id() { return (unsigned)__builtin_amdgcn_s_getreg((3 << 11) | 20) & 0xFu; }
#define XB_SPIN(cond, bar) do { unsigned _sp = 0; while (cond) { __builtin_amdgcn_s_sleep(1); \
    if ((++_sp & 255u) == 0u) { if (xb_ld(&(bar)[XB_TMO])) break; if (_sp > XB_SPIN_CAP) { atomicAdd(&(bar)[XB_TMO], 1u); break; } } } } while (0)

struct XcdBarrier {
    unsigned* bar; unsigned x;
    volatile LAS unsigned* st;
};

__device__ __forceinline__ XcdBarrier xcd_barrier_post(unsigned* bar, volatile LAS unsigned* st) {
    XcdBarrier b; b.bar = bar; b.x = xb_xcc_id(); b.st = st;
    if (threadIdx.x == 0) (void)xb_add(&bar[XB_XCNT(b.x)], 1u);
    return b;
}
__device__ __forceinline__ void xcd_barrier_complete(unsigned* bar, unsigned x, unsigned& nloc, unsigned& nx) {
    const unsigned G = gridDim.x * gridDim.y * gridDim.z;
    unsigned sum, cnt, mine, sp = 0u;
    for (;;) {
        sum = 0u; cnt = 0u; mine = 0u;
#pragma unroll
        for (unsigned j = 0; j < 16; ++j) { const unsigned c = xb_ld(&bar[XB_XCNT(j)]); sum += c; cnt += (c > 0u) ? 1u : 0u; mine = (j == x) ? c : mine; }
        if (sum == G) break;
        __builtin_amdgcn_s_sleep(1);
        if ((++sp & 255u) == 0u) { if (xb_ld(&bar[XB_TMO])) break; if (sp > XB_SPIN_CAP) { atomicAdd(&bar[XB_TMO], 1u); break; } }
    }
    nloc = mine > 0u ? mine : 1u; nx = cnt > 0u ? cnt : 1u;
}

__device__ __forceinline__ void xcd_barrier(const XcdBarrier& b) {
    asm volatile("s_waitcnt vmcnt(0)" ::: "memory");
    __syncthreads();
    if (threadIdx.x == 0) {
        unsigned* bar = b.bar;
        __builtin_amdgcn_s_waitcnt(0);
        unsigned nloc = b.st[0], nx = b.st[1];
        if (nloc == 0u) { xcd_barrier_complete(bar, b.x, nloc, nx); b.st[0] = nloc; b.st[1] = nx; }
        const unsigned old = xb_add(&bar[XB_XSUB(b.x)], 1u);
        const unsigned gen = old / nloc;
        if (old + 1u == (gen + 1u) * nloc) {
            __builtin_amdgcn_fence(__ATOMIC_RELEASE, "agent");
            asm volatile("s_waitcnt vmcnt(0)" ::: "memory");
            const unsigned og = xb_add(&bar[XB_TOP], 1u);
            const unsigned tg = og / nx;
            if (og + 1u == (tg + 1u) * nx) xb_add(&bar[XB_TOPGEN], 1u);
            else XB_SPIN(xb_ld(&bar[XB_TOPGEN]) == tg, bar);
            __builtin_amdgcn_fence(__ATOMIC_ACQUIRE, "agent");
            xb_add(&bar[XB_XGEN(b.x)], 1u);
            asm volatile("s_waitcnt vmcnt(0)" ::: "memory");
        } else {
            XB_SPIN(xb_ld(&bar[XB_XGEN(b.x)]) == gen, bar);
            __builtin_amdgcn_fence(__ATOMIC_ACQUIRE, "agent");
            asm volatile("s_waitcnt vmcnt(0)" ::: "memory");
        }
    }
    __syncthreads();
}

__device__ __forceinline__ int fresh_tid(int wave) { int l = (int)__builtin_amdgcn_mbcnt_hi(~0u, __builtin_amdgcn_mbcnt_lo(~0u, 0u)); asm volatile("" : "+v"(l)); return wave * 64 + l; }
struct Args { const float* in[15]; float* out; unsigned char* ws; float invf[16]; };

__global__ void __launch_bounds__(NWAVES * 64, 2) mk_fwd(Args args) {
    extern __shared__ __attribute__((aligned(16))) unsigned char lds[];
    cg::grid_group grid = cg::this_grid();
    LAS unsigned char* L = (LAS unsigned char*)lds;
    const int wave = __builtin_amdgcn_readfirstlane((int)threadIdx.x >> 6);
#define TID() fresh_tid(wave)
    const int G = gridDim.x, bx = blockIdx.x, vcu = (G % 8 == 0) ? (bx % 8) * (G / 8) + bx / 8 : bx;
    const int gw = vcu * NWAVES + wave, NGW = G * NWAVES;
    unsigned char* ws = args.ws;
    pg8::u64* ss = (pg8::u64*)(ws + WS_SS); float* cst = (float*)(ws + WS_COS); float* snt = (float*)(ws + WS_SIN);
    bf16* XA = (bf16*)(ws + WS_XA); bf16* XB = (bf16*)(ws + WS_XB); bf16* BIG = (bf16*)(ws + WS_BIG);
    const float* x = args.in[0]; float* out = args.out;
    const float QS = 0.08838834764831845f * 1.4426950408889634f;
    LAS float* scr = (LAS float*)(L + wave * 16384);

    {
        const int tid = TID(), lane = tid & 63;
        if (tid < 16) ((LAS unsigned*)(L + BARST_OFF))[tid] = 0u;
        if (bx == 0) for (int i = tid; i < XCD_BAR_WORDS; i += NWAVES * 64) ((unsigned*)(ws + WS_BAR))[i] = 0u;
        const int gt = bx * (NWAVES * 64) + tid, NGT = G * NWAVES * 64;
        for (int i = gt; i < 4 * TOK; i += NGT) ss[TOK + i] = 0ull;
        for (int i = gt; i < SEQ * 16; i += NGT) { const int t = i >> 4, f = i & 15; const float ang = (float)t * args.invf[f]; float s_, c_; sincos_d((double)ang, s_, c_); cst[i] = c_; snt[i] = s_; }
        for (int m = gw; m < TOK; m += 2 * NGW) {
            const f32x4* xr0 = (const f32x4*)(x + (size_t)m * DM) + lane; const f32x4* xr1 = xr0 + (size_t)NGW * (DM / 4); f32x4 v0[8], v1[8]; float s0 = 0.f, s1 = 0.f;
#pragma unroll
            for (int j = 0; j < 8; ++j) { v0[j] = xr0[64 * j]; v1[j] = xr1[64 * j]; }
#pragma unroll
            for (int j = 0; j < 8; ++j) { s0 += (v0[j][0] * v0[j][0] + v0[j][1] * v0[j][1]) + (v0[j][2] * v0[j][2] + v0[j][3] * v0[j][3]); s1 += (v1[j][0] * v1[j][0] + v1[j][1] * v1[j][1]) + (v1[j][2] * v1[j][2] + v1[j][3] * v1[j][3]); }
            s0 = wave_sum(s0); s1 = wave_sum(s1);
            v2u* o0 = (v2u*)(XA + (size_t)m * DM) + lane; v2u* o1 = o0 + (size_t)NGW * (DM / 4);
#pragma unroll
            for (int j = 0; j < 8; ++j) { v2u w; w.x = pg8::cvt_pk_bf16(v0[j][0], v0[j][1]); w.y = pg8::cvt_pk_bf16(v0[j][2], v0[j][3]); o0[64 * j] = w; w.x = pg8::cvt_pk_bf16(v1[j][0], v1[j][1]); w.y = pg8::cvt_pk_bf16(v1[j][2], v1[j][3]); o1[64 * j] = w; }
            if (lane == 0) { ss[m] = (pg8::u64)(s0 * pg8::SS_SCALE); ss[m + NGW] = (pg8::u64)(s1 * pg8::SS_SCALE); }
        }
        convert_matrix(args.in[2], DM, NQKV0, (bf16*)(ws + WS_WQKV0), args.in[1], 1, QS, scr, gw, NGW, lane);
        convert_matrix(args.in[4], DM, DM, (bf16*)(ws + WS_WO0), nullptr, 0, 1.f, scr, gw, NGW, lane);
        convert_matrix(args.in[6], DM, DFF, (bf16*)(ws + WS_W10), args.in[5], 0, 1.f, scr, gw, NGW, lane);
        convert_matrix(args.in[7], DFF, DM, (bf16*)(ws + WS_W20), nullptr, 0, 1.f, scr, gw, NGW, lane);
        convert_matrix(args.in[9], DM, NQKV1, (bf16*)(ws + WS_WQKV1), args.in[8], 2, QS, scr, gw, NGW, lane);
    }
    grid.sync();
    const XcdBarrier xbar = xcd_barrier_post((unsigned*)(ws + WS_BAR), (volatile LAS unsigned*)(L + BARST_OFF));
    {
        pg8::Gemm g{XA, (const bf16*)(ws + WS_WQKV0), TOK, NQKV0, DM, DM}; pg8::StaticOrder S; S.init(TOK, NQKV0, G, bx);
        fill_rstd(L, S, ss, TID());
        pg8::EpiRowScale<0, 1> E{BIG, NQKV0, ss, L};
        pg8::gemm_phase<pg8::EpiRowScale<0, 1>, pg8::StaticOrder, true, true>(L, g, S, E, TID());
    }
    xcd_barrier(xbar);
    att::na_phase(BIG, XA, args.in[3], L, vcu, G, TID());
    xcd_barrier(xbar);
    {
        pg8::Gemm g{XA, (const bf16*)(ws + WS_WO0), TOK, DM, DM, DM}; pg8::StaticOrder S; S.init(TOK, DM, G, bx); S.wgm = 4;
        pg8::EpiResid<true> E{x, XB, ss + TOK, L};
        pg8::gemm_phase<pg8::EpiResid<true>, pg8::StaticOrder, true, true>(L, g, S, E, TID());
    }
    xcd_barrier(xbar);
    {
        pg8::Gemm g{XB, (const bf16*)(ws + WS_W10), TOK, DFF, DM, DM}; pg8::StaticOrder S; S.init(TOK, DFF, G, bx);
        fill_rstd(L, S, ss + TOK, TID());
        pg8::EpiRowScale<1, 0> E{BIG, LDH, ss + TOK, L};
        pg8::gemm_phase<pg8::EpiRowScale<1, 0>, pg8::StaticOrder, true, true>(L, g, S, E, TID());
    }
    xcd_barrier(xbar);
    {
        pg8::Gemm g{BIG, (const bf16*)(ws + WS_W20), TOK, DM, DFF, LDH}; pg8::StaticOrder S; S.init(TOK, DM, G, bx); S.wgm = 4;
        pg8::EpiResid<false> E{XB, XA, ss + 2 * TOK, L};
        pg8::gemm_phase<pg8::EpiResid<false>, pg8::StaticOrder, true, true>(L, g, S, E, TID());
    }
    xcd_barrier(xbar);
    {
        const int lane = TID() & 63;
        convert_matrix(args.in[10], 1024, DM, (bf16*)(ws + WS_WO1), nullptr, 0, 1.f, scr, gw, NGW, lane);
        convert_matrix(args.in[12], DM, DFF, (bf16*)(ws + WS_W11), args.in[11], 0, 1.f, scr, gw, NGW, lane);
        convert_matrix(args.in[13], DFF, DM, (bf16*)(ws + WS_W21), nullptr, 0, 1.f, scr, gw, NGW, lane);
        __syncthreads();
        pg8::Gemm g{XA, (const bf16*)(ws + WS_WQKV1), TOK, NQKV1, DM, DM}; pg8::StaticOrder S; S.init(TOK, NQKV1, G, bx);
        fill_rstd(L, S, ss + 2 * TOK, TID());
        pg8::EpiQkvRope E{BIG, NQKV1, ss + 2 * TOK, cst, snt, L};
        pg8::gemm_phase<pg8::EpiQkvRope, pg8::StaticOrder, true, true>(L, g, S, E, TID());
    }
    xcd_barrier(xbar);
    att::dil_phase(BIG, (bf16*)out + (size_t)bx * (3 * 512 * 128), XB, L, vcu, G, TID());
    xcd_barrier(xbar);
    {
        pg8::Gemm g{XB, (const bf16*)(ws + WS_WO1), TOK, DM, 1024, 1024}; pg8::StaticOrder S; S.init(TOK, DM, G, bx); S.wgm = 4;
        pg8::EpiResid<false> E{XA, XA, ss + 3 * TOK, L};
        pg8::gemm_phase<pg8::EpiResid<false>, pg8::StaticOrder, true, true>(L, g, S, E, TID());
    }
    xcd_barrier(xbar);
    {
        pg8::Gemm g{XA, (const bf16*)(ws + WS_W11), TOK, DFF, DM, DM}; pg8::StaticOrder S; S.init(TOK, DFF, G, bx);
        fill_rstd(L, S, ss + 3 * TOK, TID());
        pg8::EpiRowScale<1, 0> E{BIG, LDH, ss + 3 * TOK, L};
        pg8::gemm_phase<pg8::EpiRowScale<1, 0>, pg8::StaticOrder, true, true>(L, g, S, E, TID());
    }
    xcd_barrier(xbar);
    {
        pg8::Gemm g{BIG, (const bf16*)(ws + WS_W21), TOK, DM, DFF, LDH}; pg8::StaticOrder S; S.init(TOK, DM, G, bx); S.wgm = 4;
        pg8::EpiResid<false> E{XA, XA, ss + 4 * TOK, L};
        pg8::gemm_phase<pg8::EpiResid<false>, pg8::StaticOrder, true, true>(L, g, S, E, TID());
    }
    xcd_barrier(xbar);
    {
        const int lane = TID() & 63;
        const float* gf = args.in[14]; const pg8::u64* ss4 = ss + 4 * TOK;
        for (int m0 = gw; m0 < TOK; m0 += 2 * NGW) {
            v4u bb[2][4]; float rs[2];
#pragma unroll
            for (int q = 0; q < 2; ++q) { const int m = m0 + q * NGW; const v4u* xr = (const v4u*)(XA + (size_t)m * DM) + lane; rs[q] = pg8::rstd_of(ss4, m);
#pragma unroll
                for (int j = 0; j < 4; ++j) bb[q][j] = xr[64 * j]; }
            const f32x4* gr = (const f32x4*)gf;
#pragma unroll
            for (int q = 0; q < 2; ++q) { f32x4* orow = (f32x4*)(out + (size_t)(m0 + q * NGW) * DM);
#pragma unroll
                for (int j = 0; j < 4; ++j) { const v4u b = bb[q][j]; const int c4 = (64 * j + lane) * 2;
                    const f32x4 v0 = {__uint_as_float(b.x << 16), __uint_as_float(b.x & 0xffff0000u), __uint_as_float(b.y << 16), __uint_as_float(b.y & 0xffff0000u)};
                    const f32x4 v1 = {__uint_as_float(b.z << 16), __uint_as_float(b.z & 0xffff0000u), __uint_as_float(b.w << 16), __uint_as_float(b.w & 0xffff0000u)};
                    orow[c4] = v0 * rs[q] * gr[c4]; orow[c4 + 1] = v1 * rs[q] * gr[c4 + 1]; } }
        }
    }
}

extern "C" void kernel_launch(void* const* d_in, const int* in_sizes, int n_in, void* d_out, int out_size, void* d_ws, size_t ws_size, hipStream_t stream) {
    static int grid = 0;
    if (grid == 0) {
        if (n_in != 15 || in_sizes[0] != TOK * DM || out_size != TOK * DM || ws_size < WS_END + 32 * MiB) { fprintf(stderr, "kernel_launch: unexpected shapes / workspace (n_in %d, ws %zu); nothing launched\n", n_in, ws_size); grid = -1; return; }
        int dev = 0, cus = 0, per_cu = 0;
        if (hipGetDevice(&dev) != hipSuccess || hipDeviceGetAttribute(&cus, hipDeviceAttributeMultiprocessorCount, dev) != hipSuccess) { grid = -1; return; }
        if (hipFuncSetAttribute((const void*)mk_fwd, hipFuncAttributeMaxDynamicSharedMemorySize, LDS_BYTES) != hipSuccess) { fprintf(stderr, "kernel_launch: hipFuncSetAttribute failed\n"); grid = -1; return; }
        if (hipOccupancyMaxActiveBlocksPerMultiprocessor(&per_cu, (const void*)mk_fwd, NWAVES * 64, LDS_BYTES) != hipSuccess || per_cu < 1) { fprintf(stderr, "kernel_launch: occupancy query gave %d\n", per_cu); per_cu = 1; }
        (void)hipGetLastError();
        grid = cus * per_cu;
    }
    if (grid < 0) return;
    Args a{};
    for (int i = 0; i < 15; ++i) a.in[i] = (const float*)d_in[i];
    a.out = (float*)d_out; a.ws = (unsigned char*)d_ws;
    for (int i = 0; i < 16; ++i) a.invf[i] = (float)pow(500000.0, -(double)i / 16.0);
    void* kargs[] = {&a};
    const hipError_t e = hipLaunchCooperativeKernel((const void*)mk_fwd, dim3(grid), dim3(NWAVES * 64), kargs, LDS_BYTES, stream);
    if (e != hipSuccess) fprintf(stderr, "kernel_launch: cooperative launch failed: %s (grid %d)\n", hipGetErrorString(e), grid);
}
```

```cpp
#include <hip/hip_runtime.h>
#include <hip/hip_cooperative_groups.h>
#include <cstdio>
#include <cstdint>
#include <cmath>
namespace cg = cooperative_groups;
namespace pg8 {
#define PG8_LAS __attribute__((address_space(3)))
typedef unsigned short bf16_t;
typedef short bf16x8 __attribute__((ext_vector_type(8)));
typedef float f32x4 __attribute__((ext_vector_type(4)));
typedef unsigned u32x4 __attribute__((ext_vector_type(4)));
constexpr int BM = 256, BK = 64, HALF = 128, HTB = HALF * BK * 2  , STAGE_BYTES = 8 * HTB, NXCD = 8, WGM = 8;

__host__ __device__ __forceinline__ int lds_byte(int r, int c) { const int st = (r >> 4) * 2 + (c >> 5), rr = r & 15, cc = c & 31, ob = rr * 64 + cc * 2; return st * 1024 + (ob ^ (((ob >> 9) & 1) << 5)); }
__host__ __device__ __forceinline__ void stage_rc(int b, int& R, int& C) { const int st = b / 1024, sb = b % 1024, swz = sb ^ (((sb >> 9) & 1) << 5); R = (st >> 1) * 16 + swz / 64; C = (st & 1) * 32 + (swz % 64) / 2; }
__host__ __device__ __forceinline__ int perm32(int rho) { const int n = rho >> 4, i = rho & 15; return 8 * (i >> 2) + 4 * n + (i & 3); }

struct Unit { int pm, pn; };
struct Gemm { const bf16_t* A; const bf16_t* Bt; int M, N, K, lda; };

struct StaticOrder {
    int nM, nN, nwg, G, c, wgm;
    __host__ __device__ void init(int M, int N, int G_, int c_) { nM = M / BM; nN = N / BM; nwg = nM * nN; G = G_; c = c_; wgm = WGM; }
    __host__ __device__ bool next(int i, Unit& u) const {
        const long L = (long)i * G + c; if (L >= nwg) return false;
        int wgid = (int)L; { const int q = nwg / NXCD, r = nwg % NXCD, xcd = wgid % NXCD, off = wgid / NXCD; wgid = (xcd < r ? xcd * (q + 1) : r * (q + 1) + (xcd - r) * q) + off; }
        const int nig = wgm * nN, gid = wgid / nig, fm = gid * wgm, gsz = (nM - fm) < wgm ? (nM - fm) : wgm;
        u.pm = fm + ((wgid % nig) % gsz); u.pn = (wgid % nig) / gsz; return true;
    }
    __device__ __forceinline__ void a_ready(const Unit&) const {}
    __device__ __forceinline__ void done(const Unit&) const {}
};

__device__ __forceinline__ unsigned cvt_pk_bf16(float lo, float hi) { unsigned r; asm volatile("v_cvt_pk_bf16_f32 %0, %1, %2" : "=v"(r) : "v"(lo), "v"(hi)); return r; }
typedef float f32x2 __attribute__((ext_vector_type(2)));
template <class Epi, class Sched, bool ALIGN_EPI = false, bool SP2 = false>
__device__ __forceinline__ void gemm_phase(PG8_LAS unsigned char* lds, const Gemm g, const Sched& S, const Epi& E, int tid_in) {
    int tid_ = tid_in; asm volatile("" : "+v"(tid_)); const int tid = tid_, wid = __builtin_amdgcn_readfirstlane(tid >> 6), lane = tid & 63, wr = wid >> 2, wc = wid & 3, fr = lane & 15, fq = lane >> 4;
    const int K = g.K, nt = K / BK;
    unsigned voffA[2], voffB[2];
#pragma unroll
    for (int i = 0; i < 2; ++i) { int R, C; stage_rc(tid * 16 + i * 8192, R, C); const int Rb = 2 * (R & ~31) + (Epi::PERM ? perm32(R & 31) : (R & 31));
        voffA[i] = (unsigned)(R * g.lda + C) * 2u; voffB[i] = (unsigned)(Rb * K + C) * 2u; }
    const size_t kstep = (size_t)(BK * 2);
    const size_t hstep = (size_t)HALF * g.lda * 2;
    const size_t hstepB = (size_t)32 * K * 2;
    const size_t tstep = 2 * hstep, tstepB = (size_t)BM * K * 2;
    const unsigned ldsw = (unsigned)wid * 1024u;
    const int aoff = lds_byte(wr * 64 + fr, fq * 8), boff = lds_byte(wc * 32 + fr, fq * 8);
#define PG8_SA(b, h) (((b) * 2 + (h)) * HTB)
#define PG8_SB(b, h) ((4 + (b) * 2 + (h)) * HTB)
#define PG8_STAGE(bufoff, gbase, voff) do { _Pragma("unroll") for (int _i = 0; _i < 2; ++_i) \
        __builtin_amdgcn_global_load_lds((const unsigned*)((const char*)(gbase) + (voff)[_i]), (PG8_LAS unsigned*)(lds + (bufoff) + ldsw + _i * 8192), 16, 0, 0); } while (0)
#define PG8_LDA(dst, b, h) do { _Pragma("unroll") for (int m = 0; m < 4; ++m) _Pragma("unroll") for (int k = 0; k < 2; ++k) dst[m][k] = *(const PG8_LAS bf16x8*)(lds + PG8_SA(b, h) + aoff + m * 2048 + k * 1024); } while (0)
#define PG8_LDB(dst, b, h) do { _Pragma("unroll") for (int n = 0; n < 2; ++n) _Pragma("unroll") for (int k = 0; k < 2; ++k) dst[n][k] = *(const PG8_LAS bf16x8*)(lds + PG8_SB(b, h) + boff + n * 2048 + k * 1024); } while (0)
#define PG8_MMA(ai, bj, At, Bt) do { __builtin_amdgcn_s_setprio(1); _Pragma("unroll") for (int m = 0; m < 4; ++m) _Pragma("unroll") for (int n = 0; n < 2; ++n) _Pragma("unroll") for (int k = 0; k < 2; ++k) \
        acc[ai][bj][m][n] = __builtin_amdgcn_mfma_f32_16x16x32_bf16(Bt[n][k], At[m][k], acc[ai][bj][m][n], 0, 0, 0); __builtin_amdgcn_s_setprio(0); } while (0)
#define PG8_WAIT_V(n) asm volatile("s_waitcnt vmcnt(" #n ")" ::: "memory")
#define PG8_WAIT_L(n) asm volatile("s_waitcnt lgkmcnt(" #n ")" ::: "memory")
#define PG8_BAR __builtin_amdgcn_s_barrier()
#define PG8_SCHED __builtin_amdgcn_sched_barrier(0)
    Unit cur, nxt; int ui = 0;
    if (!S.next(0, cur)) return;
    f32x4 acc[2][2][4][2];
#pragma unroll
    for (int a = 0; a < 2; ++a)
#pragma unroll
        for (int b = 0; b < 2; ++b)
#pragma unroll
            for (int m = 0; m < 4; ++m)
#pragma unroll
                for (int n = 0; n < 2; ++n) acc[a][b][m][n] = (f32x4){0.f, 0.f, 0.f, 0.f};
    bf16x8 At[4][2], B0[2][2], B1[2][2];
    const char* cA = (const char*)g.A + (size_t)cur.pm * tstep; const char* cB = (const char*)g.Bt + (size_t)cur.pn * tstepB;
    S.a_ready(cur);
    if constexpr (SP2) {
        PG8_STAGE(PG8_SB(0, 0), cB, voffB); PG8_STAGE(PG8_SB(0, 1), cB + hstepB, voffB); PG8_STAGE(PG8_SA(0, 0), cA, voffA); PG8_STAGE(PG8_SA(0, 1), cA + hstep, voffA);
        if (wr == 1) PG8_BAR;
        PG8_WAIT_V(2); PG8_BAR;
        PG8_STAGE(PG8_SB(1, 0), cB + kstep, voffB); PG8_STAGE(PG8_SA(1, 0), cA + kstep, voffA); PG8_STAGE(PG8_SB(1, 1), cB + hstepB + kstep, voffB);
        PG8_WAIT_V(6); PG8_BAR;
    } else {
        PG8_STAGE(PG8_SB(0, 0), cB, voffB); PG8_STAGE(PG8_SA(0, 0), cA, voffA); PG8_STAGE(PG8_SB(0, 1), cB + hstepB, voffB); PG8_STAGE(PG8_SA(0, 1), cA + hstep, voffA);
        if (wr == 1) PG8_BAR;
        PG8_WAIT_V(4); PG8_BAR;
        PG8_STAGE(PG8_SB(1, 0), cB + kstep, voffB); PG8_STAGE(PG8_SA(1, 0), cA + kstep, voffA); PG8_STAGE(PG8_SB(1, 1), cB + hstepB + kstep, voffB);
        PG8_WAIT_V(6); PG8_BAR;
    }
    for (;;) {
        const bool has_next = S.next(ui + 1, nxt);
        const char* nA = has_next ? (const char*)g.A + (size_t)nxt.pm * tstep : cA; const char* nB = has_next ? (const char*)g.Bt + (size_t)nxt.pn * tstepB : cB;
        for (int t = 0; t < nt; t += 2) {
            const bool last = (t == nt - 2);
            const char* a1 = cA + (size_t)(t + 1) * kstep;
            const char* a2 = last ? nA : cA + (size_t)(t + 2) * kstep; const char* b2 = last ? nB : cB + (size_t)(t + 2) * kstep;
            const char* a3 = a2 + kstep; const char* b3 = b2 + kstep;
            if (last && has_next) S.a_ready(nxt);
            if constexpr (SP2) {
            PG8_LDB(B0, 0, 0); PG8_LDB(B1, 0, 1); PG8_SCHED; PG8_LDA(At, 0, 0); PG8_STAGE(PG8_SA(1, 1), a1 + hstep, voffA);
            PG8_WAIT_V(8); PG8_WAIT_L(0); PG8_BAR; PG8_MMA(0, 0, At, B0); PG8_MMA(0, 1, At, B1); PG8_BAR; PG8_SCHED;
            PG8_LDA(At, 0, 1); PG8_STAGE(PG8_SB(0, 0), b2, voffB); PG8_STAGE(PG8_SB(0, 1), b2 + hstepB, voffB); PG8_STAGE(PG8_SA(0, 0), a2, voffA);
            PG8_WAIT_V(8); PG8_WAIT_L(0); PG8_BAR; PG8_MMA(1, 0, At, B0); PG8_MMA(1, 1, At, B1); PG8_BAR; PG8_SCHED;
            PG8_LDB(B0, 1, 0); PG8_LDB(B1, 1, 1); PG8_SCHED; PG8_LDA(At, 1, 0); PG8_STAGE(PG8_SA(0, 1), a2 + hstep, voffA);
            PG8_WAIT_V(8); PG8_WAIT_L(0); PG8_BAR; PG8_MMA(0, 0, At, B0); PG8_MMA(0, 1, At, B1); PG8_BAR; PG8_SCHED;
            PG8_LDA(At, 1, 1); PG8_STAGE(PG8_SB(1, 0), b3, voffB); PG8_STAGE(PG8_SB(1, 1), b3 + hstepB, voffB); PG8_STAGE(PG8_SA(1, 0), a3, voffA);
            PG8_WAIT_V(8); PG8_WAIT_L(0); PG8_BAR; PG8_MMA(1, 0, At, B0); PG8_MMA(1, 1, At, B1); PG8_BAR; PG8_SCHED;
            } else {
            PG8_LDB(B0, 0, 0); PG8_SCHED; PG8_LDA(At, 0, 0); PG8_STAGE(PG8_SA(1, 1), a1 + hstep, voffA);
            PG8_WAIT_L(8); PG8_BAR; PG8_WAIT_L(0); PG8_MMA(0, 0, At, B0); PG8_BAR; PG8_SCHED;
            PG8_LDB(B1, 0, 1); PG8_STAGE(PG8_SB(0, 0), b2, voffB);
            PG8_BAR; PG8_WAIT_L(0); PG8_MMA(0, 1, At, B1); PG8_BAR;
            PG8_LDA(At, 0, 1); PG8_STAGE(PG8_SA(0, 0), a2, voffA);
            PG8_BAR; PG8_WAIT_L(0); PG8_MMA(1, 0, At, B0); PG8_BAR; PG8_SCHED;
            PG8_STAGE(PG8_SB(0, 1), b2 + hstepB, voffB);
            PG8_WAIT_V(6); PG8_BAR; PG8_MMA(1, 1, At, B1); PG8_BAR;
            PG8_LDB(B0, 1, 0); PG8_SCHED; PG8_LDA(At, 1, 0); PG8_STAGE(PG8_SA(0, 1), a2 + hstep, voffA);
            PG8_WAIT_L(8); PG8_BAR; PG8_WAIT_L(0); PG8_MMA(0, 0, At, B0); PG8_BAR; PG8_SCHED;
            PG8_LDB(B1, 1, 1); PG8_STAGE(PG8_SB(1, 0), b3, voffB);
            PG8_BAR; PG8_WAIT_L(0); PG8_MMA(0, 1, At, B1); PG8_BAR;
            PG8_LDA(At, 1, 1); PG8_STAGE(PG8_SA(1, 0), a3, voffA);
            PG8_BAR; PG8_WAIT_L(0); PG8_MMA(1, 0, At, B0); PG8_BAR; PG8_SCHED;
            PG8_STAGE(PG8_SB(1, 1), b3 + hstepB, voffB);
            PG8_WAIT_V(6); PG8_BAR; PG8_MMA(1, 1, At, B1); PG8_BAR;
            }
        }
        if constexpr (ALIGN_EPI) { if (wr == 0) PG8_BAR; }
        if constexpr (!Epi::AFTER_DRAIN) { E(acc, cur, wr, wc, fr, fq); S.done(cur); }
        if (!has_next) break;
#pragma unroll
        for (int a = 0; a < 2; ++a)
#pragma unroll
            for (int b = 0; b < 2; ++b)
#pragma unroll
                for (int m = 0; m < 4; ++m)
#pragma unroll
                    for (int n = 0; n < 2; ++n) acc[a][b][m][n] = (f32x4){0.f, 0.f, 0.f, 0.f};
        cur = nxt; cA = nA; cB = nB; ++ui;
        if constexpr (ALIGN_EPI) { if (wr == 1) PG8_BAR; }
    }
    PG8_WAIT_V(0);
    if constexpr (!ALIGN_EPI) { if (wr == 0) PG8_BAR; }
    PG8_BAR;
    if constexpr (Epi::AFTER_DRAIN) { E.fused(acc, cur, wr, wc, fr, fq, lds, wid, lane); S.done(cur); }
#undef PG8_SA
#undef PG8_SB
#undef PG8_STAGE
#undef PG8_LDA
#undef PG8_LDB
#undef PG8_MMA
#undef PG8_WAIT_V
#undef PG8_WAIT_L
#undef PG8_BAR
#undef PG8_SCHED
}
}
namespace pg8 {
typedef unsigned u32x2 __attribute__((ext_vector_type(2)));
constexpr float RMS_EPS = 1e-6f;
typedef unsigned long long u64;
constexpr float SS_SCALE = 1048576.0f;
__device__ __forceinline__ float rstd_of(const u64* ss, int row) { return __builtin_amdgcn_rsqf((float)ss[row] * (1.0f / (2048.0f * SS_SCALE)) + RMS_EPS); }

constexpr int STG_ROW = 144, STG_WAVE = 16 * STG_ROW, STG_OFF = 131072, RSTD_OFF = STG_OFF + 8 * STG_WAVE;
constexpr size_t PLANE = (size_t)32768 * 128;
template <int LAYOUT> __device__ __forceinline__ void staged_store_bf16(PG8_LAS unsigned char* stg, bf16_t* O, size_t ldc, int rowg0, int pn, int wc, int lane) {
    const int p = lane & 7;
#pragma unroll
    for (int hr = 0; hr < 2; ++hr) { const int r = 8 * hr + (lane >> 3), rowg = rowg0 + r; const u32x4 w = *(const PG8_LAS u32x4*)(stg + r * STG_ROW + p * 16);
        if (LAYOUT == 0) __builtin_nontemporal_store(w, (u32x4*)(O + (size_t)rowg * ldc + pn * BM + wc * 64 + p * 8));
        else { const int P = 2 * pn + (wc >> 1); int drow = rowg;
            if (LAYOUT == 2) { const int sh = 2 * (P / 24), t = rowg & 16383; drow = (rowg & ~16383) + ((t & ((1 << sh) - 1)) << (14 - sh)) + (t >> sh); }
            __builtin_nontemporal_store(w, (u32x4*)(O + (size_t)P * PLANE + (size_t)drow * 128 + (wc & 1) * 64 + p * 8)); } }
}
template <int ACT, int LAYOUT> struct EpiRowScale {
    static constexpr bool PERM = true, AFTER_DRAIN = false;
    bf16_t* O; int ldc; const u64* ss; PG8_LAS unsigned char* lds;
    __device__ __forceinline__ void operator()(const f32x4 (&acc)[2][2][4][2], const Unit& u, int wr, int wc, int fr, int fq) const {
        const int lane = fr + 16 * fq; PG8_LAS unsigned char* stg = lds + STG_OFF + (wr * 4 + wc) * STG_WAVE;
        const PG8_LAS float* rtab = (const PG8_LAS float*)(lds + RSTD_OFF) + ((u.pm >> 3) & 3) * 256;
#pragma unroll
        for (int ai = 0; ai < 2; ++ai)
#pragma unroll
            for (int m = 0; m < 4; ++m) {
                const int rowg0 = u.pm * BM + ai * HALF + wr * 64 + m * 16; const float rs = rtab[ai * HALF + wr * 64 + m * 16 + fr];
#pragma unroll
                for (int bj = 0; bj < 2; ++bj) {
                    f32x4 v0 = acc[ai][bj][m][0] * rs, v1 = acc[ai][bj][m][1] * rs;
                    if (ACT == 1) { const f32x4 z = {0.f, 0.f, 0.f, 0.f}; v0 = __builtin_elementwise_max(v0, z); v1 = __builtin_elementwise_max(v1, z); v0 = v0 * v0; v1 = v1 * v1; }
                    u32x4 w; w.x = cvt_pk_bf16(v0[0], v0[1]); w.y = cvt_pk_bf16(v0[2], v0[3]); w.z = cvt_pk_bf16(v1[0], v1[1]); w.w = cvt_pk_bf16(v1[2], v1[3]);
                    *(PG8_LAS u32x4*)(stg + fr * STG_ROW + bj * 64 + fq * 16) = w; }
                staged_store_bf16<LAYOUT>(stg, O, (size_t)ldc, rowg0, u.pn, wc, lane);
            }
    }
};
struct EpiQkvRope {
    static constexpr bool PERM = false, AFTER_DRAIN = false;
    bf16_t* O; int ldc; const u64* ss; const float* cst; const float* snt; PG8_LAS unsigned char* lds;
    __device__ __forceinline__ void operator()(const f32x4 (&acc)[2][2][4][2], const Unit& u, int wr, int wc, int fr, int fq) const {
        const int lane = fr + 16 * fq; PG8_LAS unsigned char* stg = lds + STG_OFF + (wr * 4 + wc) * STG_WAVE;
        const bool rot = ((wc & 1) == 0) && (((u.pn >> 2) % 3) != 2);
        const PG8_LAS float* rtab = (const PG8_LAS float*)(lds + RSTD_OFF) + ((u.pm >> 3) & 3) * 256;
#pragma unroll
        for (int ai = 0; ai < 2; ++ai)
#pragma unroll
            for (int m = 0; m < 4; ++m) {
                const int rowg0 = u.pm * BM + ai * HALF + wr * 64 + m * 16, row = rowg0 + fr; const float rs = rtab[ai * HALF + wr * 64 + m * 16 + fr];
                f32x4 c4 = {1.f, 1.f, 1.f, 1.f}, s4 = {0.f, 0.f, 0.f, 0.f};
                if (rot) { const int t = row & 16383; c4 = *(const f32x4*)(cst + t * 16 + 4 * fq); s4 = *(const f32x4*)(snt + t * 16 + 4 * fq); }
#pragma unroll
                for (int bj = 0; bj < 2; ++bj) {
                    const f32x4 a = acc[ai][bj][m][0] * rs, b = acc[ai][bj][m][1] * rs;
                    const f32x4 a2 = (bj == 0) ? a * c4 - b * s4 : a, b2 = (bj == 0) ? b * c4 + a * s4 : b;
                    u32x2 w0, w1; w0.x = cvt_pk_bf16(a2[0], a2[1]); w0.y = cvt_pk_bf16(a2[2], a2[3]); w1.x = cvt_pk_bf16(b2[0], b2[1]); w1.y = cvt_pk_bf16(b2[2], b2[3]);
                    *(PG8_LAS u32x2*)(stg + fr * STG_ROW + bj * 64 + fq * 8) = w0; *(PG8_LAS u32x2*)(stg + fr * STG_ROW + bj * 64 + 32 + fq * 8) = w1; }
                staged_store_bf16<2>(stg, O, (size_t)ldc, rowg0, u.pn, wc, lane);
            }
    }
};
template <bool BASE_F32> struct EpiResid {
    static constexpr bool PERM = false, AFTER_DRAIN = false;
    const void* base; bf16_t* out; u64* ssn; PG8_LAS unsigned char* lds;
    __device__ __forceinline__ void operator()(const f32x4 (&acc)[2][2][4][2], const Unit& u, int wr, int wc, int fr, int fq) const {
        const int lane = fr + 16 * fq, r = lane >> 2, p = lane & 3; PG8_LAS unsigned char* stg = lds + STG_OFF + (wr * 4 + wc) * STG_WAVE;
#pragma unroll
        for (int ai = 0; ai < 2; ++ai)
#pragma unroll
            for (int m = 0; m < 4; ++m) {
                const int row = u.pm * BM + ai * HALF + wr * 64 + m * 16 + r; float q = 0.f;
#pragma unroll
                for (int bj = 0; bj < 2; ++bj) {
                    const size_t off = (size_t)row * 2048 + u.pn * BM + wc * 64 + bj * 32 + 8 * p;
                    f32x4 b0, b1;
                    if (BASE_F32) { b0 = *(const f32x4*)((const float*)base + off); b1 = *(const f32x4*)((const float*)base + off + 4); }
                    else { const u32x4 bb = *(const u32x4*)((const bf16_t*)base + off);
                        b0 = (f32x4){__uint_as_float(bb.x << 16), __uint_as_float(bb.x & 0xffff0000u), __uint_as_float(bb.y << 16), __uint_as_float(bb.y & 0xffff0000u)};
                        b1 = (f32x4){__uint_as_float(bb.z << 16), __uint_as_float(bb.z & 0xffff0000u), __uint_as_float(bb.w << 16), __uint_as_float(bb.w & 0xffff0000u)}; }
#pragma unroll
                    for (int n = 0; n < 2; ++n) *(PG8_LAS f32x4*)(stg + fr * STG_ROW + n * 64 + fq * 16) = acc[ai][bj][m][n];
                    const f32x4 v0 = *(const PG8_LAS f32x4*)(stg + r * STG_ROW + p * 32) + b0, v1 = *(const PG8_LAS f32x4*)(stg + r * STG_ROW + p * 32 + 16) + b1;
                    q += ((v0[0] * v0[0] + v0[1] * v0[1]) + (v0[2] * v0[2] + v0[3] * v0[3])) + ((v1[0] * v1[0] + v1[1] * v1[1]) + (v1[2] * v1[2] + v1[3] * v1[3]));
                    u32x4 w; w.x = cvt_pk_bf16(v0[0], v0[1]); w.y = cvt_pk_bf16(v0[2], v0[3]); w.z = cvt_pk_bf16(v1[0], v1[1]); w.w = cvt_pk_bf16(v1[2], v1[3]);
                    *(u32x4*)(out + off) = w;
                }
                q += __shfl_xor(q, 1); q += __shfl_xor(q, 2);
                if (p == 0) atomicAdd(ssn + row, (u64)(q * SS_SCALE));
            }
    }
};
}

namespace att {
typedef unsigned short bf16;
typedef short bf16x8 __attribute__((ext_vector_type(8)));
typedef short s16x4 __attribute__((ext_vector_type(4)));
typedef short v4i16_t __attribute__((ext_vector_type(4)));
typedef float f32x16 __attribute__((ext_vector_type(16)));
typedef float f32x4 __attribute__((ext_vector_type(4)));
typedef float f32x2_t __attribute__((ext_vector_type(2)));
typedef __bf16 bf16x2_t __attribute__((ext_vector_type(2)));
typedef unsigned u32x4 __attribute__((ext_vector_type(4)));
typedef unsigned u32x2 __attribute__((ext_vector_type(2)));
#define ALDS __attribute__((address_space(3)))
typedef ALDS unsigned char* ldsp;
constexpr float NEGBIG = -1e30f, LOG2E = 1.4426950408889634f;
__device__ __forceinline__ unsigned cvtpk(float lo, float hi) { f32x2_t v = {lo, hi}; bf16x2_t b = __builtin_convertvector(v, bf16x2_t); return __builtin_bit_cast(unsigned, b); }
__device__ __forceinline__ s16x4 vtr(ALDS const unsigned char* p) { return __builtin_bit_cast(s16x4, __builtin_amdgcn_ds_read_tr16_b64_v4i16((ALDS v4i16_t*)p)); }
__device__ __forceinline__ float bf2f(unsigned short b) { return __uint_as_float((unsigned)b << 16); }
__device__ __forceinline__ unsigned voff(int row, int ch) { return 256u * (unsigned)row + 16u * (unsigned)(ch ^ (((row & 3) << 2) | ((row >> 2) & 3))); }

struct St { f32x16 O[4]; float m, l; };

__device__ __forceinline__ void softmax_pv(f32x16& st, const unsigned (&trB)[2], St& S) {
    float mx = st[0];
#pragma unroll
    for (int i = 1; i < 16; ++i) mx = fmaxf(mx, st[i]);
    mx = fmaxf(mx, __shfl_xor(mx, 32));
    const float mn = fmaxf(S.m, mx), alpha = __builtin_amdgcn_exp2f(S.m - mn);
    float rs = 0.f;
#pragma unroll
    for (int i = 0; i < 16; ++i) { st[i] = __builtin_amdgcn_exp2f(st[i] - mn); rs += st[i]; }
    rs += __shfl_xor(rs, 32);
    S.l = S.l * alpha + rs;
    if (__builtin_amdgcn_ballot_w64(mn > S.m) != 0ull) {
#pragma unroll
        for (int db = 0; db < 4; ++db)
#pragma unroll
            for (int i = 0; i < 16; ++i) S.O[db][i] *= alpha;
    }
    S.m = mn;
    asm volatile("" ::: "memory");
    unsigned tb0 = trB[0], tb1 = trB[1]; asm volatile("" : "+v"(tb0), "+v"(tb1));
#pragma unroll
    for (int s = 0; s < 2; ++s) {
        u32x4 pw; pw.x = cvtpk(st[8 * s + 0], st[8 * s + 1]); pw.y = cvtpk(st[8 * s + 2], st[8 * s + 3]); pw.z = cvtpk(st[8 * s + 4], st[8 * s + 5]); pw.w = cvtpk(st[8 * s + 6], st[8 * s + 7]);
        const bf16x8 pf = __builtin_bit_cast(bf16x8, pw);
#pragma unroll
        for (int db = 0; db < 4; ++db) {
            const s16x4 a0 = vtr((ALDS const unsigned char*)((tb0 ^ (unsigned)(db << 6)) + 4096u * s)), a1 = vtr((ALDS const unsigned char*)((tb1 ^ (unsigned)(db << 6)) + 4096u * s));
            const bf16x8 vf = {a0[0], a0[1], a0[2], a0[3], a1[0], a1[1], a1[2], a1[3]};
            S.O[db] = __builtin_amdgcn_mfma_f32_32x32x16_bf16(vf, pf, S.O[db], 0, 0, 0);
        }
    }
    asm volatile("" ::: "memory");
}
#define ATT_BASES(ldsbase) \
    const unsigned klb = (ldsbase) + (unsigned)(wave * 16384), vlb = klb + 8192u; const int lq = lane >> 4, chn = lane & 15; \
    const unsigned kC = klb + (unsigned)(r32 * 256 + (((r32 & 15) ^ hh) << 4)); \
    const unsigned kD = klb + (unsigned)(lq * 256 + ((chn ^ lq) << 4)); \
    const unsigned vE = vlb + (unsigned)(lq * 256 + ((chn ^ (lq << 2)) << 4)); \
    const unsigned oW = klb + (unsigned)(r32 * 256 + ((r32 & 15) << 4) + 8 * hh);     \
    unsigned trB[2]; { const int g_ = (lane >> 4) & 1, q_ = (lane & 15) >> 2, p_ = lane & 3; \
        _Pragma("unroll") for (int u = 0; u < 2; ++u) trB[u] = vlb + voff(8 * u + 4 * hh + q_, 2 * g_ + (p_ >> 1)) + 8u * (unsigned)(p_ & 1); }
#define ATT_Q_DMA() do { unsigned qo_ = kD - klb; asm volatile("" : "+v"(qo_) :: "memory");     \
        _Pragma("unroll") for (int c = 0; c < 8; ++c) \
        __builtin_amdgcn_global_load_lds((const unsigned*)(qb + 1024 * c + (qo_ ^ (unsigned)((c & 3) << 6))), (ALDS unsigned*)(klb + 1024u * c), 16, 0, 0); } while (0)
#define ATT_Q_FRAGS() do { asm volatile("s_waitcnt vmcnt(16)" ::: "memory"); \
        { unsigned kC_ = kC; asm volatile("" : "+v"(kC_)); _Pragma("unroll") for (int d0 = 0; d0 < 8; ++d0) qf[d0] = *(const ALDS bf16x8*)(kC_ ^ (unsigned)(d0 << 5)); } \
        asm volatile("s_waitcnt lgkmcnt(0)" : "+v"(qf[0]), "+v"(qf[1]), "+v"(qf[2]), "+v"(qf[3]), "+v"(qf[4]), "+v"(qf[5]), "+v"(qf[6]), "+v"(qf[7]) :: "memory"); } while (0)
#define ATT_STAGE_K() do { unsigned kD_ = kD; asm volatile("" : "+v"(kD_));     \
        _Pragma("unroll") for (int c = 0; c < 8; ++c) *(ALDS u32x4*)((kD_ ^ (unsigned)((c & 3) << 6)) + 1024u * c) = kr[c]; asm volatile("" ::: "memory"); } while (0)
#define ATT_STAGE_V() do { unsigned vE_ = vE; asm volatile("" : "+v"(vE_)); asm volatile("" ::: "memory"); \
        _Pragma("unroll") for (int c = 0; c < 8; ++c) *(ALDS u32x4*)((vE_ ^ (unsigned)((c & 3) << 4)) + 1024u * c) = vr[c]; asm volatile("" ::: "memory"); } while (0)
#define ATT_QK() do { bf16x8 kf_[8]; unsigned kC_ = kC; asm volatile("" : "+v"(kC_)); _Pragma("unroll") for (int d0 = 0; d0 < 8; ++d0) kf_[d0] = *(const ALDS bf16x8*)(kC_ ^ (unsigned)(d0 << 5)); \
        asm volatile("s_waitcnt lgkmcnt(0)" : "+v"(kf_[0]), "+v"(kf_[1]), "+v"(kf_[2]), "+v"(kf_[3]), "+v"(kf_[4]), "+v"(kf_[5]), "+v"(kf_[6]), "+v"(kf_[7]) :: "memory"); \
        st = (f32x16){0.f,0.f,0.f,0.f,0.f,0.f,0.f,0.f,0.f,0.f,0.f,0.f,0.f,0.f,0.f,0.f}; \
        _Pragma("unroll") for (int d0 = 0; d0 < 8; ++d0) st = __builtin_amdgcn_mfma_f32_32x32x16_bf16(kf_[d0], qf[d0], st, 0, 0, 0); } while (0)

__device__ __forceinline__ void na_phase(const bf16* qkv, bf16* out, const float* rpb, ldsp lds, int vcu, int G, int tid_in) {
    int tid_ = tid_in; asm volatile("" : "+v"(tid_)); const int tid = tid_, lane = tid & 63, wave = __builtin_amdgcn_readfirstlane(tid >> 6), r32 = lane & 31, hh = lane >> 5;
    ATT_BASES((unsigned)(unsigned long)lds); ALDS float* tb = (ALDS float*)(lds + 131072);
    for (int i = tid; i < 16 * 465; i += 512) tb[i] = rpb[i] * LOG2E;
    __syncthreads();
    if (wave >= 4) return;
    constexpr size_t PITCH = 128, PLANE = pg8::PLANE; constexpr int NUNITS = 2048;
    const int per = (NUNITS + G - 1) / G; const int u_lo = vcu * per, u_hi = (u_lo + per < NUNITS) ? u_lo + per : NUNITS;
    for (int U2 = 2 * u_lo; U2 < 2 * u_hi; ++U2) { const int U = U2 >> 1;
        int bh_, rq_; if (G == 256) { const int x_ = vcu >> 5, c_ = vcu & 31, i_ = U - u_lo; bh_ = x_ * 4 + (i_ >> 1); rq_ = (i_ & 1) * 32 + c_; } else { bh_ = U >> 6; rq_ = U & 63; }
        const int b = bh_ >> 4, h = bh_ & 15, row = 4 * rq_ + wave, j = U2 & 1;
        const int tokb = b * 16384, qc = 32 * j + r32;
        const char* qb = (const char*)(qkv + (size_t)h * PLANE + (size_t)(tokb + row * 64 + 32 * j) * PITCH);
        ATT_Q_DMA();
        const int rs = min(max(row - 4, 0), 248), cs = min(max(qc - 8, 0), 48);
        const char* kb = (const char*)(qkv + (size_t)(16 + h) * PLANE); const char* vb = (const char*)(qkv + (size_t)(32 + h) * PLANE);
        const unsigned lane_off = (unsigned)((lane >> 4) * (int)(PITCH * 2) + (lane & 15) * 16);
        const ALDS float* tbh = tb + h * 465;
        St S; S.m = NEGBIG; S.l = 0.f;
#pragma unroll
        for (int db = 0; db < 4; ++db)
#pragma unroll
            for (int i = 0; i < 16; ++i) S.O[db][i] = 0.f;
        u32x4 kr[8], vr[8]; f32x16 st;
#define NA_LOAD(t, dst, src) do { const int rg_ = (t) / 5, cb_ = (t) - 5 * rg_, kr0_ = rs + 4 * rg_, kc0_ = 8 * (cb_ + 3 * j); \
        _Pragma("unroll") for (int c = 0; c < 8; ++c) { const int uo_ = (tokb + (kr0_ + (c >> 1)) * 64 + kc0_ + 4 * (c & 1)) * (int)(PITCH * 2); dst[c] = *(const u32x4*)((src + (long)uo_) + lane_off);     } } while (0)
        NA_LOAD(0, kr, kb); NA_LOAD(0, vr, vb);
        bf16x8 qf[8];
        ATT_Q_FRAGS();
#pragma unroll 1
        for (int t = 0; t < 10; ++t) {
            ATT_STAGE_K();
            ATT_QK();
            if (t + 1 < 10) NA_LOAD(t + 1, kr, kb);
            const int rg = t / 5, cb = t - 5 * rg, kr0 = rs + 4 * rg, kc0 = 8 * (cb + 3 * j);
            const int drb = kr0 - row + 7, kcb = kc0 + 4 * hh;
#pragma unroll
            for (int hf = 0; hf < 4; ++hf) {
                float bvv[4];
#pragma unroll
                for (int e = 0; e < 4; ++e) { const int dc = min(max(kcb + e - qc + 15, 0), 30); bvv[e] = tbh[(drb + hf) * 31 + dc]; }
                asm volatile("" : "+v"(bvv[0]), "+v"(bvv[1]), "+v"(bvv[2]), "+v"(bvv[3]));
#pragma unroll
                for (int e = 0; e < 4; ++e) { const int i = 4 * hf + e; st[i] = ((unsigned)(kcb + e - cs) < 16u) ? st[i] + bvv[e] : NEGBIG; }
            }
            ATT_STAGE_V();
            if (t + 1 < 10) NA_LOAD(t + 1, vr, vb);
            softmax_pv(st, trB, S);
        }
#undef NA_LOAD
        const float inv = 1.0f / S.l;
        asm volatile("" ::: "memory");
#pragma unroll
        for (int db = 0; db < 4; ++db)
#pragma unroll
            for (int g4 = 0; g4 < 4; ++g4) {
                u32x2 w; w.x = cvtpk(S.O[db][4 * g4] * inv, S.O[db][4 * g4 + 1] * inv); w.y = cvtpk(S.O[db][4 * g4 + 2] * inv, S.O[db][4 * g4 + 3] * inv);
                *(ALDS u32x2*)(oW ^ (unsigned)((4 * db + g4) << 4)) = w; }
        asm volatile("" ::: "memory");
#pragma unroll
        for (int c = 0; c < 8; ++c) { const int qrow = 4 * c + lq, chunk = (chn ^ lq) ^ ((c & 3) << 2);
            const u32x4 w = *(const ALDS u32x4*)(klb + 16u * (unsigned)lane + 1024u * c);
            *(u32x4*)(out + (size_t)(tokb + row * 64 + 32 * j + qrow) * 2048 + h * 128 + chunk * 8) = w; }
        asm volatile("" ::: "memory");
    }
}

__device__ __forceinline__ void dil_phase(const bf16* qkv, bf16* scratch, bf16* merged, ldsp lds, int vcu, int G, int tid_in) {
    int tid_ = tid_in; asm volatile("" : "+v"(tid_)); const int tid = tid_, lane = tid & 63, wave = __builtin_amdgcn_readfirstlane(tid >> 6), r32 = lane & 31, hh = lane >> 5;
    ATT_BASES((unsigned)(unsigned long)lds); ALDS float* lse = (ALDS float*)(lds + 131072);
    constexpr size_t PITCH = 128, PLANE = pg8::PLANE; constexpr int NUNITS = 512;
    const int per = (NUNITS + G - 1) / G; const int u_lo = vcu * per, u_hi = (u_lo + per < NUNITS) ? u_lo + per : NUNITS;
    for (int U = u_lo; U < u_hi; ++U) {
        const int b = U >> 8, head = (U >> 5) & 7, T0 = 512 * (U & 31), tokb = b * 16384;
#pragma unroll 1
        for (int k = 0; k < 6; ++k) {
            const int it = k * 8 + wave, g = it >> 4, sub = it & 15;
            const int shift = 2 * g, L = 16384 >> shift;
            const int r = (g == 0) ? 0 : (g == 1) ? (sub & 3) : sub;
            const int m0 = (g == 0) ? (T0 + 32 * sub) : (g == 1) ? ((T0 >> 2) + 32 * (sub >> 2)) : (T0 >> 4);
            const int mq = m0 + r32, tq = (mq << shift) + r;
            const int rbase = tokb + (r << (14 - shift));
            const char* qb = (const char*)(qkv + (size_t)((g * 3 + 0) * 8 + head) * PLANE + (size_t)(rbase + m0) * PITCH);
            ATT_Q_DMA();
            const char* kb = (const char*)(qkv + (size_t)((g * 3 + 1) * 8 + head) * PLANE); const char* vb = (const char*)(qkv + (size_t)((g * 3 + 2) * 8 + head) * PLANE);
            const unsigned lane_off = (unsigned)((lane >> 4) * (int)(PITCH * 2) + (lane & 15) * 16);
            St S; S.m = NEGBIG; S.l = 0.f;
#pragma unroll
            for (int db = 0; db < 4; ++db)
#pragma unroll
                for (int i = 0; i < 16; ++i) S.O[db][i] = 0.f;
            u32x4 kr[8], vr[8]; f32x16 st;
#define DIL_LOAD(t, dst, src) do { const int mk0_ = m0 - 64 + 32 * (t); \
            _Pragma("unroll") for (int c = 0; c < 8; ++c) { const int uo_ = (rbase + mk0_ + 4 * c) * (int)(PITCH * 2); dst[c] = *(const u32x4*)((src + (long)uo_) + lane_off); } } while (0)
            DIL_LOAD(0, kr, kb); DIL_LOAD(0, vr, vb);
            bf16x8 qf[8];
            ATT_Q_FRAGS();
#pragma unroll 1
            for (int t = 0; t < 5; ++t) {
                ATT_STAGE_K();
                ATT_QK();
                if (t + 1 < 5) DIL_LOAD(t + 1, kr, kb);
                const int mkb = m0 - 64 + 32 * t + 4 * hh;
#pragma unroll
                for (int i = 0; i < 16; ++i) {
                    const int mk = mkb + (i & 3) + 8 * (i >> 2), dd = mk - mq;
                    st[i] = ((unsigned)mk < (unsigned)L && dd <= 64 && dd >= -64) ? st[i] : NEGBIG;
                }
                ATT_STAGE_V();
                if (t + 1 < 5) DIL_LOAD(t + 1, vr, vb);
                softmax_pv(st, trB, S);
            }
#undef DIL_LOAD
            const float inv = 1.0f / S.l; const int tib = tq - T0;
            asm volatile("" ::: "memory");
#pragma unroll
            for (int db = 0; db < 4; ++db)
#pragma unroll
                for (int g4 = 0; g4 < 4; ++g4) {
                    u32x2 w; w.x = cvtpk(S.O[db][4 * g4] * inv, S.O[db][4 * g4 + 1] * inv); w.y = cvtpk(S.O[db][4 * g4 + 2] * inv, S.O[db][4 * g4 + 3] * inv);
                    *(ALDS u32x2*)(oW ^ (unsigned)((4 * db + g4) << 4)) = w; }
            asm volatile("" ::: "memory");
#pragma unroll
            for (int c = 0; c < 8; ++c) { const int qrow = 4 * c + lq, chunk = (chn ^ lq) ^ ((c & 3) << 2);
                const u32x4 w = *(const ALDS u32x4*)(klb + 16u * (unsigned)lane + 1024u * c);
                *(u32x4*)(scratch + (size_t)(g * 512 + (((m0 + qrow) << shift) + r - T0)) * 128 + chunk * 8) = w; }
            asm volatile("" ::: "memory");
            if (hh == 0) lse[g * 512 + tib] = S.m + __builtin_amdgcn_logf(S.l);
        }
        asm volatile("s_waitcnt vmcnt(0) lgkmcnt(0)" ::: "memory");
        __syncthreads();
        __builtin_amdgcn_fence(__ATOMIC_ACQUIRE, "workgroup");
        {
            int t2_ = tid; asm volatile("" : "+v"(t2_));
            const int ch = t2_ & 15, tg = t2_ >> 4;
#pragma unroll 4
            for (int ps = 0; ps < 16; ++ps) {
                const int tok = ps * 32 + tg;
                const float l0 = lse[tok], l1 = lse[512 + tok], l2 = lse[1024 + tok];
                const float mx = fmaxf(l0, fmaxf(l1, l2));
                float w0 = __builtin_amdgcn_exp2f(l0 - mx), w1 = __builtin_amdgcn_exp2f(l1 - mx), w2 = __builtin_amdgcn_exp2f(l2 - mx);
                const float iw = 1.0f / (w0 + w1 + w2); w0 *= iw; w1 *= iw; w2 *= iw;
                const u32x4 a0 = *(const u32x4*)(scratch + (size_t)(tok) * 128 + ch * 8), a1 = *(const u32x4*)(scratch + (size_t)(512 + tok) * 128 + ch * 8), a2 = *(const u32x4*)(scratch + (size_t)(1024 + tok) * 128 + ch * 8);
                u32x4 o;
#pragma unroll
                for (int e = 0; e < 4; ++e) {
                    const float lo = w0 * __uint_as_float(a0[e] << 16) + w1 * __uint_as_float(a1[e] << 16) + w2 * __uint_as_float(a2[e] << 16);
                    const float hi = w0 * __uint_as_float(a0[e] & 0xffff0000u) + w1 * __uint_as_float(a1[e] & 0xffff0000u) + w2 * __uint_as_float(a2[e] & 0xffff0000u);
                    o[e] = cvtpk(lo, hi); }
                *(u32x4*)(merged + (size_t)(tokb + T0 + tok) * 1024 + head * 128 + ch * 8) = o;
            }
        }
        asm volatile("s_waitcnt vmcnt(0) lgkmcnt(0)" ::: "memory");
        __syncthreads();
    }
}
}

constexpr int NWAVES = 8;
constexpr int LDH = 8192 + 64;
constexpr int TOK = 32768, SEQ = 16384, DM = 2048, DFF = 8192, NQKV0 = 6144, NQKV1 = 9216;
constexpr size_t MiB = 1u << 20;
constexpr size_t WS_SS = 0;
constexpr size_t WS_BAR = 3 * MiB / 2;
constexpr size_t WS_COS = 2 * MiB, WS_SIN = 3 * MiB;
constexpr size_t WS_WQKV0 = 4 * MiB, WS_WO0 = 28 * MiB, WS_W10 = 36 * MiB, WS_W20 = 68 * MiB;
constexpr size_t WS_WO1 = 4 * MiB, WS_W11 = 8 * MiB, WS_W21 = 40 * MiB;
constexpr size_t WS_WQKV1 = 100 * MiB;
constexpr size_t WS_XA = 136 * MiB, WS_XB = 264 * MiB;
constexpr size_t WS_BIG = 392 * MiB;
constexpr size_t WS_END = 968 * MiB;
constexpr int LDS_BYTES = 131072 + 29760 + 64;
constexpr int BARST_OFF = 131072 + 29760;

#define GAS __attribute__((address_space(1)))
#define LAS __attribute__((address_space(3)))
typedef unsigned short bf16;
typedef unsigned v4u __attribute__((ext_vector_type(4)));
typedef unsigned v2u __attribute__((ext_vector_type(2)));
typedef float f32x4 __attribute__((ext_vector_type(4)));
#define LDS_WAIT() asm volatile("s_waitcnt lgkmcnt(0)" ::: "memory")

__device__ __forceinline__ float wave_sum(float v) {
#pragma unroll
    for (int o = 1; o < 64; o <<= 1) v += __shfl_xor(v, o);
    return v;
}
__device__ __forceinline__ void tr_load(const float* W, int N, int nblk, int item, int lane, f32x4 (&wv)[8]) {
    const int kb = item / nblk, nb = item % nblk, k0 = 64 * kb, n0 = 32 * nb;
#pragma unroll
    for (int i = 0; i < 8; ++i) wv[i] = *(const f32x4*)(W + (size_t)(k0 + 8 * i + (lane >> 3)) * N + n0 + 4 * (lane & 7));
}
__device__ __forceinline__ void tr_stage(const float* gain, int nblk, int item, int lane, const f32x4 (&wv)[8], LAS float* scr) {
    const int k0 = 64 * (item / nblk);
#pragma unroll
    for (int i = 0; i < 8; ++i) { const int kk = 8 * i + (lane >> 3); const float gk = gain ? gain[k0 + kk] : 1.0f; LAS float* d = scr + kk * 33 + 4 * (lane & 7);
        d[0] = wv[i][0] * gk; d[1] = wv[i][1] * gk; d[2] = wv[i][2] * gk; d[3] = wv[i][3] * gk; }
    LDS_WAIT(); asm volatile("" ::: "memory");
}
__device__ __forceinline__ void tr_emit(int K, int nblk, bf16* WT, int qmode, float qs, LAS float* scr, int item, int lane) {
    const int kb = item / nblk, nb = item % nblk, k0 = 64 * kb, n0 = 32 * nb, c = lane & 7;
#pragma unroll
    for (int j = 0; j < 4; ++j) { const int n = (lane >> 3) + 8 * j, ncol = n0 + n; const LAS float* s = scr + (8 * c) * 33 + n;
        float sc = 1.0f; if (qmode == 1 && ncol < 2048) sc = qs; if (qmode == 2 && ((ncol >> 10) % 3) == 0) sc = qs;
        v4u o; o.x = pg8::cvt_pk_bf16(s[0 * 33] * sc, s[1 * 33] * sc); o.y = pg8::cvt_pk_bf16(s[2 * 33] * sc, s[3 * 33] * sc); o.z = pg8::cvt_pk_bf16(s[4 * 33] * sc, s[5 * 33] * sc); o.w = pg8::cvt_pk_bf16(s[6 * 33] * sc, s[7 * 33] * sc);
        *(v4u*)(WT + (size_t)ncol * K + k0 + 8 * c) = o; }
    LDS_WAIT(); asm volatile("" ::: "memory");
}
__device__ __forceinline__ void convert_matrix(const float* W, int K, int N, bf16* WT, const float* gain, int qmode, float qs, LAS float* scr, int gw, int NGW, int lane) {
    const int nblk = N / 32, nitems = (K / 64) * nblk;
    int it = gw; if (it >= nitems) return;
    f32x4 wv[8]; tr_load(W, N, nblk, it, lane, wv);
    for (;;) {
        tr_stage(gain, nblk, it, lane, wv, scr);
        const int nx = it + NGW; const bool more = nx < nitems;
        if (more) tr_load(W, N, nblk, nx, lane, wv);
        tr_emit(K, nblk, WT, qmode, qs, scr, it, lane);
        if (!more) break;
        it = nx;
    }
}
__device__ __forceinline__ void sincos_d(double a, float& so, float& co) {
    const double k = __builtin_rint(a * 0.63661977236758134308);
    double r = __builtin_fma(-k, 1.57079632679489655800e+00, a); r = __builtin_fma(-k, 6.12323399573676603587e-17, r);
    const double r2 = r * r;
    double sp = 1.0 / 6227020800.0; sp = sp * r2 - 1.0 / 39916800.0; sp = sp * r2 + 1.0 / 362880.0; sp = sp * r2 - 1.0 / 5040.0; sp = sp * r2 + 1.0 / 120.0; sp = sp * r2 - 1.0 / 6.0; sp = sp * r2 * r + r;
    double cp = -1.0 / 87178291200.0; cp = cp * r2 + 1.0 / 479001600.0; cp = cp * r2 - 1.0 / 3628800.0; cp = cp * r2 + 1.0 / 40320.0; cp = cp * r2 - 1.0 / 720.0; cp = cp * r2 + 1.0 / 24.0; cp = cp * r2 - 0.5; cp = cp * r2 + 1.0;
    const int q = ((int)k) & 3;
    double ss = (q & 1) ? cp : sp, cc = (q & 1) ? sp : cp;
    if (q == 1) cc = -cc; else if (q == 2) { ss = -ss; cc = -cc; } else if (q == 3) ss = -ss;
    so = (float)ss; co = (float)cc;
}

__device__ __forceinline__ void fill_rstd(LAS unsigned char* L, const pg8::StaticOrder& S, const pg8::u64* ssx, int tid) {
    LAS float* tabl = (LAS float*)(L + pg8::RSTD_OFF); pg8::Unit u; int last = -1;
    for (int i = 0; S.next(i, u); ++i) { if (u.pm != last) { last = u.pm; if (tid < 256) tabl[((u.pm >> 3) & 3) * 256 + tid] = pg8::rstd_of(ssx, u.pm * 256 + tid); } }
    __syncthreads();
}
#define XB_TMO      128
#define XB_XCNT(j)  (256  + 64 * (j))
#define XB_XSUB(j)  (1280 + 64 * (j))
#define XB_XGEN(j)  (2304 + 64 * (j))
#define XB_TOP      3328
#define XB_TOPGEN   3392
#define XCD_BAR_WORDS 3456
#define XB_SPIN_CAP (1u << 18)

__device__ __forceinline__ unsigned xb_ld(unsigned* p)              { return __hip_atomic_load(p, __ATOMIC_RELAXED, __HIP_MEMORY_SCOPE_AGENT); }
__device__ __forceinline__ unsigned xb_add(unsigned* p, unsigned v) { return __hip_atomic_fetch_add(p, v, __ATOMIC_RELAXED, __HIP_MEMORY_SCOPE_AGENT); }
__device__ __forceinline__ unsigned xb_xcc_id() { return (unsigned)__builtin_amdgcn_s_getreg((3 << 11) | 20) & 0xFu; }
#define XB_SPIN(cond, bar) do { unsigned _sp = 0; while (cond) { __builtin_amdgcn_s_sleep(1); \
    if ((++_sp & 255u) == 0u) { if (xb_ld(&(bar)[XB_TMO])) break; if (_sp > XB_SPIN_CAP) { atomicAdd(&(bar)[XB_TMO], 1u); break; } } } } while (0)

struct XcdBarrier {
    unsigned* bar; unsigned x;
    volatile LAS unsigned* st;
};

__device__ __forceinline__ XcdBarrier xcd_barrier_post(unsigned* bar, volatile LAS unsigned* st) {
    XcdBarrier b; b.bar = bar; b.x = xb_xcc_id(); b.st = st;
    if (threadIdx.x == 0) (void)xb_add(&bar[XB_XCNT(b.x)], 1u);
    return b;
}
__device__ __forceinline__ void xcd_barrier_complete(unsigned* bar, unsigned x, unsigned& nloc, unsigned& nx) {
    const unsigned G = gridDim.x * gridDim.y * gridDim.z;
    unsigned sum, cnt, mine, sp = 0u;
    for (;;) {
        sum = 0u; cnt = 0u; mine = 0u;
#pragma unroll
        for (unsigned j = 0; j < 16; ++j) { const unsigned c = xb_ld(&bar[XB_XCNT(j)]); sum += c; cnt += (c > 0u) ? 1u : 0u; mine = (j == x) ? c : mine; }
        if (sum == G) break;
        __builtin_amdgcn_s_sleep(1);
        if ((++sp & 255u) == 0u) { if (xb_ld(&bar[XB_TMO])) break; if (sp > XB_SPIN_CAP) { atomicAdd(&bar[XB_TMO], 1u); break; } }
    }
    nloc = mine > 0u ? mine : 1u; nx = cnt > 0u ? cnt : 1u;
}

__device__ __forceinline__ void xcd_barrier(const XcdBarrier& b) {
    asm volatile("s_waitcnt vmcnt(0)" ::: "memory");
    __syncthreads();
    if (threadIdx.x == 0) {
        unsigned* bar = b.bar;
        __builtin_amdgcn_s_waitcnt(0);
        unsigned nloc = b.st[0], nx = b.st[1];
        if (nloc == 0u) { xcd_barrier_complete(bar, b.x, nloc, nx); b.st[0] = nloc; b.st[1] = nx; }
        const unsigned old = xb_add(&bar[XB_XSUB(b.x)], 1u);
        const unsigned gen = old / nloc;
        if (old + 1u == (gen + 1u) * nloc) {
            __builtin_amdgcn_fence(__ATOMIC_RELEASE, "agent");
            asm volatile("s_waitcnt vmcnt(0)" ::: "memory");
            const unsigned og = xb_add(&bar[XB_TOP], 1u);
            const unsigned tg = og / nx;
            if (og + 1u == (tg + 1u) * nx) xb_add(&bar[XB_TOPGEN], 1u);
            else XB_SPIN(xb_ld(&bar[XB_TOPGEN]) == tg, bar);
            __builtin_amdgcn_fence(__ATOMIC_ACQUIRE, "agent");
            xb_add(&bar[XB_XGEN(b.x)], 1u);
            asm volatile("s_waitcnt vmcnt(0)" ::: "memory");
        } else {
            XB_SPIN(xb_ld(&bar[XB_XGEN(b.x)]) == gen, bar);
            __builtin_amdgcn_fence(__ATOMIC_ACQUIRE, "agent");
            asm volatile("s_waitcnt vmcnt(0)" ::: "memory");
        }
    }
    __syncthreads();
}

__device__ __forceinline__ int fresh_tid(int wave) { int l = (int)__builtin_amdgcn_mbcnt_hi(~0u, __builtin_amdgcn_mbcnt_lo(~0u, 0u)); asm volatile("" : "+v"(l)); return wave * 64 + l; }
struct Args { const float* in[15]; float* out; unsigned char* ws; float invf[16]; };

__global__ void __launch_bounds__(NWAVES * 64, 2) mk_fwd(Args args) {
    extern __shared__ __attribute__((aligned(16))) unsigned char lds[];
    cg::grid_group grid = cg::this_grid();
    LAS unsigned char* L = (LAS unsigned char*)lds;
    const int wave = __builtin_amdgcn_readfirstlane((int)threadIdx.x >> 6);
#define TID() fresh_tid(wave)
    const int G = gridDim.x, bx = blockIdx.x, vcu = (G % 8 == 0) ? (bx % 8) * (G / 8) + bx / 8 : bx;
    const int gw = vcu * NWAVES + wave, NGW = G * NWAVES;
    unsigned char* ws = args.ws;
    pg8::u64* ss = (pg8::u64*)(ws + WS_SS); float* cst = (float*)(ws + WS_COS); float* snt = (float*)(ws + WS_SIN);
    bf16* XA = (bf16*)(ws + WS_XA); bf16* XB = (bf16*)(ws + WS_XB); bf16* BIG = (bf16*)(ws + WS_BIG);
    bf16* W_O1 = (bf16*)((unsigned char*)args.out + 128 * MiB); bf16* W_11 = (bf16*)((unsigned char*)args.out + 132 * MiB); bf16* W_21 = (bf16*)((unsigned char*)args.out + 164 * MiB);
    const float* x = args.in[0]; float* out = args.out;
    const float QS = 0.08838834764831845f * 1.4426950408889634f;
    LAS float* scr = (LAS float*)(L + wave * 16384);

    {
        const int tid = TID(), lane = tid & 63;
        if (tid < 16) ((LAS unsigned*)(L + BARST_OFF))[tid] = 0u;
        if (bx == 0) for (int i = tid; i < XCD_BAR_WORDS; i += NWAVES * 64) ((unsigned*)(ws + WS_BAR))[i] = 0u;
        const int gt = bx * (NWAVES * 64) + tid, NGT = G * NWAVES * 64;
        for (int i = gt; i < 4 * TOK; i += NGT) ss[TOK + i] = 0ull;
        for (int i = gt; i < SEQ * 16; i += NGT) { const int t = i >> 4, f = i & 15; const float ang = (float)t * args.invf[f]; float s_, c_; sincos_d((double)ang, s_, c_); cst[i] = c_; snt[i] = s_; }
        for (int m = gw; m < TOK; m += 2 * NGW) {
            const f32x4* xr0 = (const f32x4*)(x + (size_t)m * DM) + lane; const f32x4* xr1 = xr0 + (size_t)NGW * (DM / 4); f32x4 v0[8], v1[8]; float s0 = 0.f, s1 = 0.f;
#pragma unroll
            for (int j = 0; j < 8; ++j) { v0[j] = xr0[64 * j]; v1[j] = xr1[64 * j]; }
#pragma unroll
            for (int j = 0; j < 8; ++j) { s0 += (v0[j][0] * v0[j][0] + v0[j][1] * v0[j][1]) + (v0[j][2] * v0[j][2] + v0[j][3] * v0[j][3]); s1 += (v1[j][0] * v1[j][0] + v1[j][1] * v1[j][1]) + (v1[j][2] * v1[j][2] + v1[j][3] * v1[j][3]); }
            s0 = wave_sum(s0); s1 = wave_sum(s1);
            v2u* o0 = (v2u*)(XA + (size_t)m * DM) + lane; v2u* o1 = o0 + (size_t)NGW * (DM / 4);
#pragma unroll
            for (int j = 0; j < 8; ++j) { v2u w; w.x = pg8::cvt_pk_bf16(v0[j][0], v0[j][1]); w.y = pg8::cvt_pk_bf16(v0[j][2], v0[j][3]); o0[64 * j] = w; w.x = pg8::cvt_pk_bf16(v1[j][0], v1[j][1]); w.y = pg8::cvt_pk_bf16(v1[j][2], v1[j][3]); o1[64 * j] = w; }
            if (lane == 0) { ss[m] = (pg8::u64)(s0 * pg8::SS_SCALE); ss[m + NGW] = (pg8::u64)(s1 * pg8::SS_SCALE); }
        }
        convert_matrix(args.in[2], DM, NQKV0, (bf16*)(ws + WS_WQKV0), args.in[1], 1, QS, scr, gw, NGW, lane);
    }
    grid.sync();
    const XcdBarrier xbar = xcd_barrier_post((unsigned*)(ws + WS_BAR), (volatile LAS unsigned*)(L + BARST_OFF));
    {
        pg8::Gemm g{XA, (const bf16*)(ws + WS_WQKV0), TOK, NQKV0, DM, DM}; pg8::StaticOrder S; S.init(TOK, NQKV0, G, bx);
        fill_rstd(L, S, ss, TID());
        pg8::EpiRowScale<0, 1> E{BIG, NQKV0, ss, L};
        pg8::gemm_phase<pg8::EpiRowScale<0, 1>, pg8::StaticOrder, true, true>(L, g, S, E, TID());
    }
    xcd_barrier(xbar);
    att::na_phase(BIG, XA, args.in[3], L, vcu, G, TID());
    if (wave >= 4) {
        const int lane = TID() & 63, gw4 = vcu * 4 + (wave - 4), NGW4 = G * 4;
        convert_matrix(args.in[4], DM, DM, (bf16*)(ws + WS_WO0), nullptr, 0, 1.f, scr, gw4, NGW4, lane);
        convert_matrix(args.in[6], DM, DFF, (bf16*)(ws + WS_W10), args.in[5], 0, 1.f, scr, gw4, NGW4, lane);
        convert_matrix(args.in[7], DFF, DM, (bf16*)(ws + WS_W20), nullptr, 0, 1.f, scr, gw4, NGW4, lane);
        convert_matrix(args.in[9], DM, NQKV1, (bf16*)(ws + WS_WQKV1), args.in[8], 2, QS, scr, gw4, NGW4, lane);
        convert_matrix(args.in[10], 1024, DM, W_O1, nullptr, 0, 1.f, scr, gw4, NGW4, lane);
        convert_matrix(args.in[12], DM, DFF, W_11, args.in[11], 0, 1.f, scr, gw4, NGW4, lane);
        convert_matrix(args.in[13], DFF, DM, W_21, nullptr, 0, 1.f, scr, gw4, NGW4, lane);
    }
    xcd_barrier(xbar);
    {
        pg8::Gemm g{XA, (const bf16*)(ws + WS_WO0), TOK, DM, DM, DM}; pg8::StaticOrder S; S.init(TOK, DM, G, bx); S.wgm = 4;
        pg8::EpiResid<true> E{x, XB, ss + TOK, L};
        pg8::gemm_phase<pg8::EpiResid<true>, pg8::StaticOrder, true, true>(L, g, S, E, TID());
    }
    xcd_barrier(xbar);
    {
        pg8::Gemm g{XB, (const bf16*)(ws + WS_W10), TOK, DFF, DM, DM}; pg8::StaticOrder S; S.init(TOK, DFF, G, bx);
        fill_rstd(L, S, ss + TOK, TID());
        pg8::EpiRowScale<1, 0> E{BIG, LDH, ss + TOK, L};
        pg8::gemm_phase<pg8::EpiRowScale<1, 0>, pg8::StaticOrder, true, true>(L, g, S, E, TID());
    }
    xcd_barrier(xbar);
    {
        pg8::Gemm g{BIG, (const bf16*)(ws + WS_W20), TOK, DM, DFF, LDH}; pg8::StaticOrder S; S.init(TOK, DM, G, bx); S.wgm = 4;
        pg8::EpiResid<false> E{XB, XA, ss + 2 * TOK, L};
        pg8::gemm_phase<pg8::EpiResid<false>, pg8::StaticOrder, true, true>(L, g, S, E, TID());
    }
    xcd_barrier(xbar);
    {
        pg8::Gemm g{XA, (const bf16*)(ws + WS_WQKV1), TOK, NQKV1, DM, DM}; pg8::StaticOrder S; S.init(TOK, NQKV1, G, bx);
        fill_rstd(L, S, ss + 2 * TOK, TID());
        pg8::EpiQkvRope E{BIG, NQKV1, ss + 2 * TOK, cst, snt, L};
        pg8::gemm_phase<pg8::EpiQkvRope, pg8::StaticOrder, true, true>(L, g, S, E, TID());
    }
    xcd_barrier(xbar);
    att::dil_phase(BIG, (bf16*)out + (size_t)bx * (3 * 512 * 128), XB, L, vcu, G, TID());
    xcd_barrier(xbar);
    {
        pg8::Gemm g{XB, W_O1, TOK, DM, 1024, 1024}; pg8::StaticOrder S; S.init(TOK, DM, G, bx); S.wgm = 4;
        pg8::EpiResid<false> E{XA, XA, ss + 3 * TOK, L};
        pg8::gemm_phase<pg8::EpiResid<false>, pg8::StaticOrder, true, true>(L, g, S, E, TID());
    }
    xcd_barrier(xbar);
    {
        pg8::Gemm g{XA, W_11, TOK, DFF, DM, DM}; pg8::StaticOrder S; S.init(TOK, DFF, G, bx);
        fill_rstd(L, S, ss + 3 * TOK, TID());
        pg8::EpiRowScale<1, 0> E{BIG, LDH, ss + 3 * TOK, L};
        pg8::gemm_phase<pg8::EpiRowScale<1, 0>, pg8::StaticOrder, true, true>(L, g, S, E, TID());
    }
    xcd_barrier(xbar);
    {
        pg8::Gemm g{BIG, W_21, TOK, DM, DFF, LDH}; pg8::StaticOrder S; S.init(TOK, DM, G, bx); S.wgm = 4;
        pg8::EpiResid<false> E{XA, XA, ss + 4 * TOK, L};
        pg8::gemm_phase<pg8::EpiResid<false>, pg8::StaticOrder, true, true>(L, g, S, E, TID());
    }
    xcd_barrier(xbar);
    {
        const int lane = TID() & 63;
        const float* gf = args.in[14]; const pg8::u64* ss4 = ss + 4 * TOK;
        for (int m0 = gw; m0 < TOK; m0 += 2 * NGW) {
            v4u bb[2][4]; float rs[2];
#pragma unroll
            for (int q = 0; q < 2; ++q) { const int m = m0 + q * NGW; const v4u* xr = (const v4u*)(XA + (size_t)m * DM) + lane; rs[q] = pg8::rstd_of(ss4, m);
#pragma unroll
                for (int j = 0; j < 4; ++j) bb[q][j] = xr[64 * j]; }
            const f32x4* gr = (const f32x4*)gf;
#pragma unroll
            for (int q = 0; q < 2; ++q) { f32x4* orow = (f32x4*)(out + (size_t)(m0 + q * NGW) * DM);
#pragma unroll
                for (int j = 0; j < 4; ++j) { const v4u b = bb[q][j]; const int c4 = (64 * j + lane) * 2;
                    const f32x4 v0 = {__uint_as_float(b.x << 16), __uint_as_float(b.x & 0xffff0000u), __uint_as_float(b.y << 16), __uint_as_float(b.y & 0xffff0000u)};
                    const f32x4 v1 = {__uint_as_float(b.z << 16), __uint_as_float(b.z & 0xffff0000u), __uint_as_float(b.w << 16), __uint_as_float(b.w & 0xffff0000u)};
                    orow[c4] = v0 * rs[q] * gr[c4]; orow[c4 + 1] = v1 * rs[q] * gr[c4 + 1]; } }
        }
    }
}

extern "C" void kernel_launch(void* const* d_in, const int* in_sizes, int n_in, void* d_out, int out_size, void* d_ws, size_t ws_size, hipStream_t stream) {
    static int grid = 0;
    if (grid == 0) {
        if (n_in != 15 || in_sizes[0] != TOK * DM || out_size != TOK * DM || ws_size < WS_END + 32 * MiB) { fprintf(stderr, "kernel_launch: unexpected shapes / workspace (n_in %d, ws %zu); nothing launched\n", n_in, ws_size); grid = -1; return; }
        int dev = 0, cus = 0, per_cu = 0;
        if (hipGetDevice(&dev) != hipSuccess || hipDeviceGetAttribute(&cus, hipDeviceAttributeMultiprocessorCount, dev) != hipSuccess) { grid = -1; return; }
        if (hipFuncSetAttribute((const void*)mk_fwd, hipFuncAttributeMaxDynamicSharedMemorySize, LDS_BYTES) != hipSuccess) { fprintf(stderr, "kernel_launch: hipFuncSetAttribute failed\n"); grid = -1; return; }
        if (hipOccupancyMaxActiveBlocksPerMultiprocessor(&per_cu, (const void*)mk_fwd, NWAVES * 64, LDS_BYTES) != hipSuccess || per_cu < 1) { fprintf(stderr, "kernel_launch: occupancy query gave %d\n", per_cu); per_cu = 1; }
        (void)hipGetLastError();
        grid = cus * per_cu;
    }
    if (grid < 0) return;
    Args a{};
    for (int i = 0; i < 15; ++i) a.in[i] = (const float*)d_in[i];
    a.out = (float*)d_out; a.ws = (unsigned char*)d_ws;
    for (int i = 0; i < 16; ++i) a.invf[i] = (float)pow(500000.0, -(double)i / 16.0);
    void* kargs[] = {&a};
    const hipError_t e = hipLaunchCooperativeKernel((const void*)mk_fwd, dim3(grid), dim3(NWAVES * 64), kargs, LDS_BYTES, stream);
    if (e != hipSuccess) fprintf(stderr, "kernel_launch: cooperative launch failed: %s (grid %d)\n", hipGetErrorString(e), grid);
}
```
